# Optimizing an MI355X kernel written in HIP

```python
import jax, jax.numpy as jnp
from jax import lax
import numpy as np

D_MODEL = 2048
BATCH = 4
SEQ = 4096
DEPTH = 1

N_HEADS = 16
HEAD_DIM = 128
D_ATTN = N_HEADS * HEAD_DIM
MOBA_BLOCK = 256
MOBA_TOPK = 3
Q_CHUNK = 16
ROPE_THETA = 500000.0
ROT_DIM = HEAD_DIM // 4
D_RNN = 2048
N_RNN_BLOCKS = 16
RNN_BLOCK = D_RNN // N_RNN_BLOCKS
CONV_WIDTH = 4
LRU_C = 8.0
MEM_LEN = 256
MEM_HEADS = 4
MEM_HEAD_DIM = 128
D_MEM = MEM_HEADS * MEM_HEAD_DIM
D_FF = -(-8 * D_MODEL // (3 * 256)) * 256
IN_WIDTH = 2 * D_RNN + 3 * D_ATTN + 2 * D_MODEL
RMS_EPS = 1e-6
NEG_INF = -1e30

kernel_name = "hawk_moba_gated_hybrid"


def rmsnorm(x, g):
    xf = x.astype(jnp.float32)
    y = xf * lax.rsqrt(jnp.mean(xf * xf, axis=-1, keepdims=True) + RMS_EPS)
    return (y * g.astype(jnp.float32)).astype(x.dtype)


def partial_rope(x, positions):
    half = ROT_DIM // 2
    inv_freq = jnp.power(ROPE_THETA, -jnp.arange(half, dtype=jnp.float32) / half)
    ang = positions.astype(jnp.float32)[..., None] * inv_freq
    cos = jnp.cos(ang)[:, :, None, :]
    sin = jnp.sin(ang)[:, :, None, :]
    xf = x.astype(jnp.float32)
    x1 = xf[..., :half]
    x2 = xf[..., half:ROT_DIM]
    out = jnp.concatenate([x1 * cos - x2 * sin, x2 * cos + x1 * sin, xf[..., ROT_DIM:]], axis=-1)
    return out.astype(x.dtype)


def causal_depthwise_conv(x, w, b):
    y = lax.conv_general_dilated(
        x, w[:, None, :].astype(x.dtype), window_strides=(1,),
        padding=[(CONV_WIDTH - 1, 0)], dimension_numbers=("NWC", "WIO", "NWC"),
        feature_group_count=x.shape[-1])
    return y + b.astype(x.dtype)


def rg_lru(x, w_a, b_a, w_i, b_i, lam):
    B, S, _ = x.shape
    xb = x.reshape(B, S, N_RNN_BLOCKS, RNN_BLOCK)
    r = jax.nn.sigmoid(jnp.einsum('bsnk,nkj->bsnj', xb, w_a, preferred_element_type=jnp.float32)
                       .reshape(B, S, D_RNN) + b_a.astype(jnp.float32))
    i = jax.nn.sigmoid(jnp.einsum('bsnk,nkj->bsnj', xb, w_i, preferred_element_type=jnp.float32)
                       .reshape(B, S, D_RNN) + b_i.astype(jnp.float32))
    log_a = -LRU_C * r * jax.nn.softplus(-lam.astype(jnp.float32))
    a = jnp.exp(log_a)
    u = jnp.sqrt(-jnp.expm1(2.0 * log_a)) * (i * x.astype(jnp.float32))

    def combine(left, right):
        a1, b1 = left
        a2, b2 = right
        return a1 * a2, a2 * b1 + b2

    _, h = lax.associative_scan(combine, (a, u), axis=1)
    return h.astype(x.dtype)


def moba_attention(q, k, v):
    B, H, S, dh = q.shape
    nb = -(-S // MOBA_BLOCK)
    s_pad = nb * MOBA_BLOCK
    k_sel = min(MOBA_TOPK, nb)
    scale = dh ** -0.5
    pad = ((0, 0), (0, 0), (0, s_pad - S), (0, 0))
    kp = jnp.pad(k, pad)
    vp = jnp.pad(v, pad)
    k_blocks = kp.reshape(B, H, nb, MOBA_BLOCK, dh)
    v_blocks = vp.reshape(B, H, nb, MOBA_BLOCK, dh)
    k_mean = jnp.mean(k_blocks.astype(jnp.float32), axis=3)

    q_blk = jnp.arange(S) // MOBA_BLOCK
    gate = jnp.einsum('bhsd,bhnd->bhsn', q.astype(jnp.float32), k_mean)
    past = jnp.arange(nb)[None, :] < q_blk[:, None]
    gate = jnp.where(past, gate, -jnp.inf)
    _, sel_idx = lax.top_k(gate, k_sel)

    bi = jnp.arange(B)[:, None, None, None]
    hi = jnp.arange(H)[None, :, None, None]
    sel_width = k_sel * MOBA_BLOCK

    def chunk(c):
        start = c * Q_CHUNK
        qc = lax.dynamic_slice_in_dim(q, start, Q_CHUNK, axis=2)
        idx = lax.dynamic_slice_in_dim(sel_idx, start, Q_CHUNK, axis=2)
        pos = start + jnp.arange(Q_CHUNK)
        n_past = pos // MOBA_BLOCK
        valid = jnp.arange(k_sel)[None, :] < n_past[:, None]
        kg = k_blocks[bi, hi, idx]
        vg = v_blocks[bi, hi, idx]
        s_sel = jnp.einsum('bhqd,bhqnkd->bhqnk', qc, kg, preferred_element_type=jnp.float32) * scale
        s_sel = jnp.where(valid[None, None, :, :, None], s_sel, NEG_INF)
        own_start = (start // MOBA_BLOCK) * MOBA_BLOCK
        ko = lax.dynamic_slice_in_dim(kp, own_start, MOBA_BLOCK, axis=2)
        vo = lax.dynamic_slice_in_dim(vp, own_start, MOBA_BLOCK, axis=2)
        s_own = jnp.einsum('bhqd,bhkd->bhqk', qc, ko, preferred_element_type=jnp.float32) * scale
        causal = (own_start + jnp.arange(MOBA_BLOCK))[None, :] <= pos[:, None]
        s_own = jnp.where(causal[None, None], s_own, NEG_INF)
        s_all = jnp.concatenate([s_sel.reshape(B, H, Q_CHUNK, sel_width), s_own], axis=-1)
        p = jax.nn.softmax(s_all, axis=-1)
        p_sel = p[..., :sel_width].reshape(B, H, Q_CHUNK, k_sel, MOBA_BLOCK).astype(v.dtype)
        p_own = p[..., sel_width:].astype(v.dtype)
        o = (jnp.einsum('bhqnk,bhqnkd->bhqd', p_sel, vg, preferred_element_type=jnp.float32)
             + jnp.einsum('bhqk,bhkd->bhqd', p_own, vo, preferred_element_type=jnp.float32))
        return o.astype(q.dtype)

    out = lax.map(chunk, jnp.arange(S // Q_CHUNK))
    return out.transpose(1, 2, 0, 3, 4).reshape(B, H, S, dh)


def hybrid_mixer(h, positions, w_in, conv_w, conv_b, w_a, b_a, w_i, b_i, lam,
                 w_rnn_proj, w_attn_proj, w_mix_out):
    B, S, _ = h.shape
    proj = h @ w_in
    o0 = 0
    xr = proj[..., o0:o0 + D_RNN]; o0 += D_RNN
    yr = proj[..., o0:o0 + D_RNN]; o0 += D_RNN
    q = proj[..., o0:o0 + D_ATTN]; o0 += D_ATTN
    k = proj[..., o0:o0 + D_ATTN]; o0 += D_ATTN
    v = proj[..., o0:o0 + D_ATTN]; o0 += D_ATTN
    g_rnn = proj[..., o0:o0 + D_MODEL]; o0 += D_MODEL
    g_attn = proj[..., o0:o0 + D_MODEL]

    hr = rg_lru(causal_depthwise_conv(xr, conv_w, conv_b), w_a, b_a, w_i, b_i, lam)
    rnn_out = (jax.nn.gelu(yr) * hr) @ w_rnn_proj

    q = partial_rope(q.reshape(B, S, N_HEADS, HEAD_DIM), positions).transpose(0, 2, 1, 3)
    k = partial_rope(k.reshape(B, S, N_HEADS, HEAD_DIM), positions).transpose(0, 2, 1, 3)
    v = v.reshape(B, S, N_HEADS, HEAD_DIM).transpose(0, 2, 1, 3)
    o = moba_attention(q, k, v).transpose(0, 2, 1, 3).reshape(B, S, D_ATTN)
    attn_out = o @ w_attn_proj

    merged = jax.nn.sigmoid(g_rnn) * rnn_out + jax.nn.sigmoid(g_attn) * attn_out
    return merged @ w_mix_out


def memory_cross_attention(h, mem_n, w_q, w_kv, w_o):
    B, S, _ = h.shape
    M = mem_n.shape[1]
    q = (h @ w_q).reshape(B, S, MEM_HEADS, MEM_HEAD_DIM)
    kv = mem_n @ w_kv
    k = kv[..., :D_MEM].reshape(B, M, MEM_HEADS, MEM_HEAD_DIM)
    v = kv[..., D_MEM:].reshape(B, M, MEM_HEADS, MEM_HEAD_DIM)
    s = jnp.einsum('bshd,bmhd->bhsm', q, k, preferred_element_type=jnp.float32) * (MEM_HEAD_DIM ** -0.5)
    p = jax.nn.softmax(s, axis=-1).astype(v.dtype)
    o = jnp.einsum('bhsm,bmhd->bshd', p, v)
    return o.reshape(B, S, D_MEM) @ w_o


def swiglu(h, w_gate, w_up, w_down):
    return (jax.nn.silu(h @ w_gate) * (h @ w_up)) @ w_down


def setup_inputs(seed: int = 0) -> dict:
    key = jax.random.key(seed)
    ks = jax.random.split(key, 32)
    f32 = jnp.float32

    def nrm(k, shape, fan_in):
        return jax.random.normal(k, shape, f32) * (fan_in ** -0.5)

    def gain(k, shape):
        return 1.0 + 0.02 * jax.random.normal(k, shape, f32)

    def bias(k, shape):
        return 0.01 * jax.random.normal(k, shape, f32)

    L = DEPTH
    x = jax.random.normal(ks[0], (BATCH, SEQ, D_MODEL), f32)
    mem = jax.random.normal(ks[1], (BATCH, MEM_LEN, D_MODEL), f32)
    offset = jax.random.randint(ks[2], (BATCH, 1), 0, 1024, dtype=jnp.int32)
    positions = (offset + jnp.arange(SEQ, dtype=jnp.int32)[None, :]).astype(jnp.int32)
    a_init = jax.random.uniform(ks[3], (L, D_RNN), f32, 0.9, 0.999)
    lru_lambda = jnp.log(a_init) - jnp.log1p(-a_init)
    return {
        "x": x,
        "mem": mem,
        "positions": positions,
        "norm_mix_g": gain(ks[4], (L, D_MODEL)),
        "w_in": nrm(ks[5], (L, D_MODEL, IN_WIDTH), D_MODEL),
        "conv_w": nrm(ks[6], (L, CONV_WIDTH, D_RNN), CONV_WIDTH),
        "conv_b": bias(ks[7], (L, D_RNN)),
        "lru_w_a": nrm(ks[8], (L, N_RNN_BLOCKS, RNN_BLOCK, RNN_BLOCK), RNN_BLOCK),
        "lru_b_a": bias(ks[9], (L, D_RNN)),
        "lru_w_i": nrm(ks[10], (L, N_RNN_BLOCKS, RNN_BLOCK, RNN_BLOCK), RNN_BLOCK),
        "lru_b_i": bias(ks[11], (L, D_RNN)),
        "lru_lambda": lru_lambda,
        "w_rnn_proj": nrm(ks[12], (L, D_RNN, D_MODEL), D_RNN),
        "w_attn_proj": nrm(ks[13], (L, D_ATTN, D_MODEL), D_ATTN),
        "w_mix_out": nrm(ks[14], (L, D_MODEL, D_MODEL), D_MODEL),
        "norm_xq_g": gain(ks[15], (L, D_MODEL)),
        "norm_mem_g": gain(ks[16], (L, D_MODEL)),
        "w_xq": nrm(ks[17], (L, D_MODEL, D_MEM), D_MODEL),
        "w_xkv": nrm(ks[18], (L, D_MODEL, 2 * D_MEM), D_MODEL),
        "w_xo": nrm(ks[19], (L, D_MEM, D_MODEL), D_MEM),
        "norm_ffn_g": gain(ks[20], (L, D_MODEL)),
        "w_ffn_gate": nrm(ks[21], (L, D_MODEL, D_FF), D_MODEL),
        "w_ffn_up": nrm(ks[22], (L, D_MODEL, D_FF), D_MODEL),
        "w_ffn_down": nrm(ks[23], (L, D_FF, D_MODEL), D_FF),
        "norm_final_g": gain(ks[24], (D_MODEL,)),
    }


def reference(x, mem, positions, norm_mix_g, w_in, conv_w, conv_b, lru_w_a, lru_b_a,
              lru_w_i, lru_b_i, lru_lambda, w_rnn_proj, w_attn_proj, w_mix_out,
              norm_xq_g, norm_mem_g, w_xq, w_xkv, w_xo, norm_ffn_g, w_ffn_gate,
              w_ffn_up, w_ffn_down, norm_final_g):
    for l in range(DEPTH):
        h = rmsnorm(x, norm_mix_g[l])
        x = x + hybrid_mixer(h, positions, w_in[l], conv_w[l], conv_b[l], lru_w_a[l], lru_b_a[l],
                             lru_w_i[l], lru_b_i[l], lru_lambda[l], w_rnn_proj[l],
                             w_attn_proj[l], w_mix_out[l])
        h = rmsnorm(x, norm_xq_g[l])
        mem_n = rmsnorm(mem, norm_mem_g[l])
        x = x + memory_cross_attention(h, mem_n, w_xq[l], w_xkv[l], w_xo[l])
        h = rmsnorm(x, norm_ffn_g[l])
        x = x + swiglu(h, w_ffn_gate[l], w_ffn_up[l], w_ffn_down[l])
    return rmsnorm(x, norm_final_g)
```

```cpp
#include <hip/hip_runtime.h>
#include <hip/hip_cooperative_groups.h>
#include <cstdio>
#include <cstdint>
namespace cg = cooperative_groups;
namespace pg8 {
#define PG8_LAS __attribute__((address_space(3)))
typedef unsigned short bf16_t;
typedef short bf16x8 __attribute__((ext_vector_type(8)));
typedef float f32x4 __attribute__((ext_vector_type(4)));
typedef unsigned u32x4 __attribute__((ext_vector_type(4)));
constexpr int BM = 256, BK = 64, HALF = 128, HTB = HALF * BK * 2  , STAGE_BYTES = 8 * HTB, NXCD = 8, WGM = 4;

__host__ __device__ __forceinline__ int lds_byte(int r, int c) { const int st = (r >> 4) * 2 + (c >> 5), rr = r & 15, cc = c & 31, ob = rr * 64 + cc * 2; return st * 1024 + (ob ^ (((ob >> 9) & 1) << 5)); }
__host__ __device__ __forceinline__ void stage_rc(int b, int& R, int& C) { const int st = b / 1024, sb = b % 1024, swz = sb ^ (((sb >> 9) & 1) << 5); R = (st >> 1) * 16 + swz / 64; C = (st & 1) * 32 + (swz % 64) / 2; }
__host__ __device__ __forceinline__ int perm32(int rho) { const int n = rho >> 4, i = rho & 15; return 8 * (i >> 2) + 4 * n + (i & 3); }

struct Unit { int pm, pn; };
struct Gemm { const bf16_t* A; const bf16_t* Bt; int M, N, K; const bf16_t* A2 = nullptr; const bf16_t* Bt2 = nullptr; int nt2 = 0; };

struct StaticOrder {
    int nM, nN, nwg, G, c, wgm;
    __host__ __device__ void init(int M, int N, int G_, int c_, int wgm_ = WGM) { nM = M / BM; nN = N / BM; nwg = nM * nN; G = G_; c = c_; wgm = wgm_; }
    __host__ __device__ bool next(int i, Unit& u) const {
        const long L = (long)i * G + c; if (L >= nwg) return false;
        int wgid = (int)L; { const int q = nwg / NXCD, r = nwg % NXCD, xcd = wgid % NXCD, off = wgid / NXCD; wgid = (xcd < r ? xcd * (q + 1) : r * (q + 1) + (xcd - r) * q) + off; }
        const int nig = wgm * nN, gid = wgid / nig, fm = gid * wgm, gsz = (nM - fm) < wgm ? (nM - fm) : wgm;
        u.pm = fm + ((wgid % nig) % gsz); u.pn = (wgid % nig) / gsz; return true;
    }
    __device__ __forceinline__ void a_ready(const Unit&) const {}
    __device__ __forceinline__ void done(const Unit&) const {}
};

__device__ __forceinline__ unsigned cvt_pk_bf16(float lo, float hi) { unsigned r; asm volatile("v_cvt_pk_bf16_f32 %0, %1, %2" : "=v"(r) : "v"(lo), "v"(hi)); return r; }
typedef float f32x2 __attribute__((ext_vector_type(2)));
template <class E, class = void> struct HasMid { static constexpr bool value = false; };
template <class E> struct HasMid<E, decltype((void)E::HAS_MID)> { static constexpr bool value = true; };
template <class Epi, class Sched, bool ALIGN_EPI = false, bool SP2 = false>
__device__ __forceinline__ void gemm_phase(PG8_LAS unsigned char* lds, const Gemm g, const Sched& S, const Epi& E) {
    int tid_l = threadIdx.x; asm volatile("" : "+v"(tid_l));
    const int tid = tid_l, wid = __builtin_amdgcn_readfirstlane(tid >> 6), lane = tid & 63, wr = wid >> 2, wc = wid & 3, fr = lane & 15, fq = lane >> 4;
    const int K = g.K, ns = K / BK, nt = ns + g.nt2;
    unsigned voffA[2], voffB[2];
#pragma unroll
    for (int i = 0; i < 2; ++i) { int R, C; stage_rc(tid * 16 + i * 8192, R, C); const int Rb = Epi::PERM ? ((R & ~31) + perm32(R & 31)) : R;
        voffA[i] = (unsigned)(R * K + C) * 2u; voffB[i] = (unsigned)(Rb * K + C) * 2u; }
    const size_t kstep = (size_t)(BK * 2);
    const size_t hstep = (size_t)HALF * K * 2;
    const size_t tstep = 2 * hstep;
    const unsigned ldsw = (unsigned)wid * 1024u;
    const int aoff = lds_byte(wr * 64 + fr, fq * 8), boff = lds_byte(wc * 32 + fr, fq * 8);
#define PG8_SA(b, h) (((b) * 2 + (h)) * HTB)
#define PG8_SB(b, h) ((4 + (b) * 2 + (h)) * HTB)
#ifndef PG8_AUX_A
#define PG8_AUX_A 0
#endif
#ifndef PG8_AUX_B
#define PG8_AUX_B 0
#endif
#define PG8_STAGE_X(bufoff, gbase, voff, AUX) do { _Pragma("unroll") for (int _i = 0; _i < 2; ++_i) \
        __builtin_amdgcn_global_load_lds((const unsigned*)((const char*)(gbase) + (voff)[_i]), (PG8_LAS unsigned*)(lds + (bufoff) + ldsw + _i * 8192), 16, 0, AUX); } while (0)
#define PG8_STAGEA(bufoff, gbase, voff) PG8_STAGE_X(bufoff, gbase, voff, PG8_AUX_A)
#define PG8_STAGEB(bufoff, gbase, voff) PG8_STAGE_X(bufoff, gbase, voff, PG8_AUX_B)
#define PG8_LDA(dst, b, h) do { _Pragma("unroll") for (int m = 0; m < 4; ++m) _Pragma("unroll") for (int k = 0; k < 2; ++k) dst[m][k] = *(const PG8_LAS bf16x8*)(lds + PG8_SA(b, h) + aoff + m * 2048 + k * 1024); } while (0)
#define PG8_LDB(dst, b, h) do { _Pragma("unroll") for (int n = 0; n < 2; ++n) _Pragma("unroll") for (int k = 0; k < 2; ++k) dst[n][k] = *(const PG8_LAS bf16x8*)(lds + PG8_SB(b, h) + boff + n * 2048 + k * 1024); } while (0)
#define PG8_MMA(ai, bj, At, Bt) do { __builtin_amdgcn_s_setprio(1); _Pragma("unroll") for (int m = 0; m < 4; ++m) _Pragma("unroll") for (int n = 0; n < 2; ++n) _Pragma("unroll") for (int k = 0; k < 2; ++k) \
        acc[ai][bj][m][n] = __builtin_amdgcn_mfma_f32_16x16x32_bf16(Bt[n][k], At[m][k], acc[ai][bj][m][n], 0, 0, 0); __builtin_amdgcn_s_setprio(0); } while (0)
#define PG8_WAIT_V(n) asm volatile("s_waitcnt vmcnt(" #n ")" ::: "memory")
#define PG8_WAIT_L(n) asm volatile("s_waitcnt lgkmcnt(" #n ")" ::: "memory")
#define PG8_BAR __builtin_amdgcn_s_barrier()
#define PG8_SCHED __builtin_amdgcn_sched_barrier(0)
    Unit cur, nxt; int ui = 0;
    if (!S.next(0, cur)) return;
    f32x4 acc[2][2][4][2];
#pragma unroll
    for (int a = 0; a < 2; ++a)
#pragma unroll
        for (int b = 0; b < 2; ++b)
#pragma unroll
            for (int m = 0; m < 4; ++m)
#pragma unroll
                for (int n = 0; n < 2; ++n) acc[a][b][m][n] = (f32x4){0.f, 0.f, 0.f, 0.f};
    bf16x8 At[4][2], B0[2][2], B1[2][2];
    const char* cA = (const char*)g.A + (size_t)cur.pm * tstep; const char* cB = (const char*)g.Bt + (size_t)cur.pn * tstep;
    const char* cA2 = g.nt2 ? (const char*)g.A2 + (size_t)cur.pm * tstep - (size_t)ns * (BK * 2) : cA; const char* cB2 = g.nt2 ? (const char*)g.Bt2 + (size_t)cur.pn * tstep - (size_t)ns * (BK * 2) : cB;
    S.a_ready(cur);
    if constexpr (SP2) {
        PG8_STAGEB(PG8_SB(0, 0), cB, voffB); PG8_STAGEB(PG8_SB(0, 1), cB + hstep, voffB); PG8_STAGEA(PG8_SA(0, 0), cA, voffA); PG8_STAGEA(PG8_SA(0, 1), cA + hstep, voffA);
        if (wr == 1) PG8_BAR;
        PG8_WAIT_V(2); PG8_BAR;
        PG8_STAGEB(PG8_SB(1, 0), cB + kstep, voffB); PG8_STAGEA(PG8_SA(1, 0), cA + kstep, voffA); PG8_STAGEB(PG8_SB(1, 1), cB + hstep + kstep, voffB);
        PG8_WAIT_V(6); PG8_BAR;
    } else {
        PG8_STAGEB(PG8_SB(0, 0), cB, voffB); PG8_STAGEA(PG8_SA(0, 0), cA, voffA); PG8_STAGEB(PG8_SB(0, 1), cB + hstep, voffB); PG8_STAGEA(PG8_SA(0, 1), cA + hstep, voffA);
        if (wr == 1) PG8_BAR;
        PG8_WAIT_V(4); PG8_BAR;
        PG8_STAGEB(PG8_SB(1, 0), cB + kstep, voffB); PG8_STAGEA(PG8_SA(1, 0), cA + kstep, voffA); PG8_STAGEB(PG8_SB(1, 1), cB + hstep + kstep, voffB);
        PG8_WAIT_V(6); PG8_BAR;
    }
    for (;;) {
        const bool has_next = S.next(ui + 1, nxt);
        const char* nA = has_next ? (const char*)g.A + (size_t)nxt.pm * tstep : cA; const char* nB = has_next ? (const char*)g.Bt + (size_t)nxt.pn * tstep : cB;
        const char* nA2 = (has_next && g.nt2) ? (const char*)g.A2 + (size_t)nxt.pm * tstep - (size_t)ns * (BK * 2) : cA2; const char* nB2 = (has_next && g.nt2) ? (const char*)g.Bt2 + (size_t)nxt.pn * tstep - (size_t)ns * (BK * 2) : cB2;
        for (int t = 0; t < nt; t += 2) {
            const bool last = (t == nt - 2);
            if constexpr (HasMid<Epi>::value) { if (t == ns) E.mid(acc, cur, wr, wc, fr, fq); }
            const char* sA1 = (t + 1 >= ns) ? cA2 : cA; const char* sA2 = (t + 2 >= ns) ? cA2 : cA; const char* sB2 = (t + 2 >= ns) ? cB2 : cB;
            const char* a1 = sA1 + (size_t)(t + 1) * kstep;
            const char* a2 = last ? nA : sA2 + (size_t)(t + 2) * kstep; const char* b2 = last ? nB : sB2 + (size_t)(t + 2) * kstep;
            const char* a3 = a2 + kstep; const char* b3 = b2 + kstep;
            if (last && has_next) S.a_ready(nxt);
            if constexpr (SP2) {
            PG8_LDB(B0, 0, 0); PG8_LDB(B1, 0, 1); PG8_SCHED; PG8_LDA(At, 0, 0); PG8_STAGEA(PG8_SA(1, 1), a1 + hstep, voffA);
            PG8_WAIT_V(8); PG8_WAIT_L(0); PG8_BAR; PG8_MMA(0, 0, At, B0); PG8_MMA(0, 1, At, B1); PG8_BAR; PG8_SCHED;
            PG8_LDA(At, 0, 1); PG8_STAGEB(PG8_SB(0, 0), b2, voffB); PG8_STAGEB(PG8_SB(0, 1), b2 + hstep, voffB); PG8_STAGEA(PG8_SA(0, 0), a2, voffA);
            PG8_WAIT_V(8); PG8_WAIT_L(0); PG8_BAR; PG8_MMA(1, 0, At, B0); PG8_MMA(1, 1, At, B1); PG8_BAR; PG8_SCHED;
            PG8_LDB(B0, 1, 0); PG8_LDB(B1, 1, 1); PG8_SCHED; PG8_LDA(At, 1, 0); PG8_STAGEA(PG8_SA(0, 1), a2 + hstep, voffA);
            PG8_WAIT_V(8); PG8_WAIT_L(0); PG8_BAR; PG8_MMA(0, 0, At, B0); PG8_MMA(0, 1, At, B1); PG8_BAR; PG8_SCHED;
            PG8_LDA(At, 1, 1); PG8_STAGEB(PG8_SB(1, 0), b3, voffB); PG8_STAGEB(PG8_SB(1, 1), b3 + hstep, voffB); PG8_STAGEA(PG8_SA(1, 0), a3, voffA);
            PG8_WAIT_V(8); PG8_WAIT_L(0); PG8_BAR; PG8_MMA(1, 0, At, B0); PG8_MMA(1, 1, At, B1); PG8_BAR; PG8_SCHED;
            } else {
            PG8_LDB(B0, 0, 0); PG8_SCHED; PG8_LDA(At, 0, 0); PG8_STAGEA(PG8_SA(1, 1), a1 + hstep, voffA);
            PG8_WAIT_L(8); PG8_BAR; PG8_WAIT_L(0); PG8_MMA(0, 0, At, B0); PG8_BAR; PG8_SCHED;
            PG8_LDB(B1, 0, 1); PG8_STAGEB(PG8_SB(0, 0), b2, voffB);
            PG8_BAR; PG8_WAIT_L(0); PG8_MMA(0, 1, At, B1); PG8_BAR;
            PG8_LDA(At, 0, 1); PG8_STAGEA(PG8_SA(0, 0), a2, voffA);
            PG8_BAR; PG8_WAIT_L(0); PG8_MMA(1, 0, At, B0); PG8_BAR; PG8_SCHED;
            PG8_STAGEB(PG8_SB(0, 1), b2 + hstep, voffB);
            PG8_WAIT_V(6); PG8_BAR; PG8_MMA(1, 1, At, B1); PG8_BAR;
            PG8_LDB(B0, 1, 0); PG8_SCHED; PG8_LDA(At, 1, 0); PG8_STAGEA(PG8_SA(0, 1), a2 + hstep, voffA);
            PG8_WAIT_L(8); PG8_BAR; PG8_WAIT_L(0); PG8_MMA(0, 0, At, B0); PG8_BAR; PG8_SCHED;
            PG8_LDB(B1, 1, 1); PG8_STAGEB(PG8_SB(1, 0), b3, voffB);
            PG8_BAR; PG8_WAIT_L(0); PG8_MMA(0, 1, At, B1); PG8_BAR;
            PG8_LDA(At, 1, 1); PG8_STAGEA(PG8_SA(1, 0), a3, voffA);
            PG8_BAR; PG8_WAIT_L(0); PG8_MMA(1, 0, At, B0); PG8_BAR; PG8_SCHED;
            PG8_STAGEB(PG8_SB(1, 1), b3 + hstep, voffB);
            PG8_WAIT_V(6); PG8_BAR; PG8_MMA(1, 1, At, B1); PG8_BAR;
            }
        }
        if constexpr (ALIGN_EPI) { if (wr == 0) PG8_BAR; }
        if constexpr (!Epi::AFTER_DRAIN) { E(acc, cur, wr, wc, fr, fq); S.done(cur); }
        if (!has_next) break;
#pragma unroll
        for (int a = 0; a < 2; ++a)
#pragma unroll
            for (int b = 0; b < 2; ++b)
#pragma unroll
                for (int m = 0; m < 4; ++m)
#pragma unroll
                    for (int n = 0; n < 2; ++n) acc[a][b][m][n] = (f32x4){0.f, 0.f, 0.f, 0.f};
        cur = nxt; cA = nA; cB = nB; cA2 = nA2; cB2 = nB2; ++ui;
        if constexpr (ALIGN_EPI) { if (wr == 1) PG8_BAR; }
    }
    PG8_WAIT_V(0);
    if constexpr (!ALIGN_EPI) { if (wr == 0) PG8_BAR; }
    PG8_BAR;
    if constexpr (Epi::AFTER_DRAIN) { E.fused(acc, cur, wr, wc, fr, fq, lds, wid, lane); S.done(cur); }
#undef PG8_SA
#undef PG8_SB
#undef PG8_STAGE_X
#undef PG8_STAGEA
#undef PG8_STAGEB
#undef PG8_LDA
#undef PG8_LDB
#undef PG8_MMA
#undef PG8_WAIT_V
#undef PG8_WAIT_L
#undef PG8_BAR
#undef PG8_SCHED
}
}

using namespace pg8;
#define LAS __attribute__((address_space(3)))
typedef float f32x16 __attribute__((ext_vector_type(16)));
typedef unsigned u32x2 __attribute__((ext_vector_type(2)));

constexpr int NB = 4, SEQ = 4096, T = NB * SEQ, D = 2048, NH = 16, HD = 128, DFF = 5632, MEML = 256, DMEM = 512;
constexpr int NIN1 = 12288;
constexpr float RMS_EPS = 1e-6f;
constexpr float QSCALE = 0.08838834764831845f * 1.4426950408889634f;
constexpr float NEGBIG = -1e30f;

constexpr size_t MiB = 1u << 20;
constexpr size_t WS_WIN = 1 * MiB;
constexpr size_t WS_WGU = WS_WIN;
constexpr size_t WS_WGATE = 57 * MiB;
constexpr size_t WS_WRNN = 58 * MiB, WS_WATTN = 66 * MiB, WS_WMIX = 74 * MiB;
constexpr size_t WS_WXQ = 82 * MiB;
constexpr size_t WS_WXKV = 84 * MiB;
constexpr size_t WS_WXO = 88 * MiB;
constexpr size_t WS_K2 = 90 * MiB;
constexpr size_t WS_V2T = 91 * MiB;
constexpr size_t WS_KMEAN = 92 * MiB;
constexpr size_t WS_CS = 93 * MiB;
constexpr size_t WS_MEMN = 95 * MiB;
constexpr size_t WS_H = 104 * MiB;
constexpr size_t WS_XR = 168 * MiB;
constexpr size_t WS_GY = 232 * MiB, WS_Q = 296 * MiB, WS_K = 360 * MiB;
constexpr size_t WS_VT = 424 * MiB;
constexpr size_t WS_WDOWN = 488 * MiB;
constexpr size_t WS_ACT = 168 * MiB;
constexpr size_t WS_Q2 = 360 * MiB, WS_O2 = 376 * MiB;
constexpr size_t WS_T1 = WS_XR;
constexpr size_t WS_END = 512 * MiB;
constexpr size_t SEG_ELEMS = (size_t)T * D;

constexpr int LDS_BYTES = 147456;
constexpr int LDS_XB_ST = 147392;
constexpr size_t WS_XBAR = 512 * 1024;

__device__ __forceinline__ unsigned f2bf(float f) { unsigned u = __builtin_bit_cast(unsigned, f); return (u + 0x7fffu + ((u >> 16) & 1u)) >> 16; }
__device__ __forceinline__ unsigned pk2(float lo, float hi) { return cvt_pk_bf16(lo, hi); }
__device__ __forceinline__ float bflo(unsigned w) { return __builtin_bit_cast(float, w << 16); }
__device__ __forceinline__ float bfhi(unsigned w) { return __builtin_bit_cast(float, w & 0xffff0000u); }
__device__ __forceinline__ float sigm(float x) { return __builtin_amdgcn_rcpf(1.f + __builtin_amdgcn_exp2f(-1.4426950408889634f * x)); }
__device__ __forceinline__ float gelu_tanh(float x) { return x * sigm(1.5957691216057308f * (x + 0.044715f * x * x * x)); }
__device__ __forceinline__ float wave_sum(float v) {
#pragma unroll
    for (int o = 1; o < 64; o <<= 1) v += __shfl_xor(v, o);
    return v;
}

__device__ __forceinline__ void st8(bf16_t* p, const f32x4& a, const f32x4& b) { u32x4 w; w.x = pk2(a[0], a[1]); w.y = pk2(a[2], a[3]); w.z = pk2(b[0], b[1]); w.w = pk2(b[2], b[3]); *(u32x4*)p = w; }

struct EpiInProj {
    static constexpr bool PERM = true, AFTER_DRAIN = false;
    bf16_t* act0; bf16_t* gate0; const float2* cs; float* kmean;
    __device__ __forceinline__ void operator()(const f32x4 (&acc)[2][2][4][2], const Unit& u, int wr, int wc, int fr, int fq) const {
        const int seg = u.pn >> 3, colt = (u.pn & 7) * 256;
        bf16_t* base = seg < 4 ? act0 + (size_t)seg * SEG_ELEMS : gate0 + (size_t)(seg - 4) * SEG_ELEMS;
        const int row0 = u.pm * 256 + wr * 64 + fr, col0 = colt + wc * 32 + 8 * fq;
        if (seg == 2 || seg == 3) {
            const bool roped = (wc == 0);
            const float sc = (seg == 2) ? QSCALE : 1.f;
            const float sgn = (fq < 2) ? -1.f : 1.f;
            f32x4 ks[2][2];
#pragma unroll
            for (int bj = 0; bj < 2; ++bj) { ks[bj][0] = (f32x4){0.f, 0.f, 0.f, 0.f}; ks[bj][1] = (f32x4){0.f, 0.f, 0.f, 0.f}; }
#pragma unroll
            for (int ai = 0; ai < 2; ++ai)
#pragma unroll
                for (int m = 0; m < 4; ++m) {
                    const int row = row0 + ai * 128 + m * 16;
                    f32x4 c0, s0, c1, s1;
                    if (roped) { const f32x4* cp = (const f32x4*)(cs + (size_t)row * 16 + 8 * (fq & 1));
                        const f32x4 t0 = cp[0], t1 = cp[1], t2 = cp[2], t3 = cp[3];
                        c0 = (f32x4){t0[0], t0[2], t1[0], t1[2]}; s0 = (f32x4){t0[1], t0[3], t1[1], t1[3]};
                        c1 = (f32x4){t2[0], t2[2], t3[0], t3[2]}; s1 = (f32x4){t2[1], t2[3], t3[1], t3[3]}; }
#pragma unroll
                    for (int bj = 0; bj < 2; ++bj) {
                        f32x4 v0 = acc[ai][bj][m][0], v1 = acc[ai][bj][m][1];
                        if (roped) {
                            f32x4 p0, p1;
#pragma unroll
                            for (int e = 0; e < 4; ++e) { p0[e] = __shfl_xor(v0[e], 32); p1[e] = __shfl_xor(v1[e], 32); }
                            v0 = v0 * c0 + (p0 * s0) * sgn; v1 = v1 * c1 + (p1 * s1) * sgn;
                        }
                        if (seg == 3) { ks[bj][0] += v0; ks[bj][1] += v1; }
                        st8(base + (size_t)row * D + col0 + bj * 128, v0 * sc, v1 * sc);
                    }
                }
            if (seg == 3) {
#pragma unroll
                for (int bj = 0; bj < 2; ++bj)
#pragma unroll
                    for (int n = 0; n < 2; ++n)
#pragma unroll
                        for (int e = 0; e < 4; ++e) { float s = ks[bj][n][e]; s += __shfl_xor(s, 1); s += __shfl_xor(s, 2); s += __shfl_xor(s, 4); s += __shfl_xor(s, 8);
                            if (fr == 0) atomicAdd(kmean + (size_t)u.pm * D + col0 + bj * 128 + 4 * n + e, s); }
            }
        } else {
#pragma unroll
            for (int ai = 0; ai < 2; ++ai)
#pragma unroll
                for (int m = 0; m < 4; ++m) {
                    const int row = row0 + ai * 128 + m * 16;
#pragma unroll
                    for (int bj = 0; bj < 2; ++bj) {
                        f32x4 v0 = acc[ai][bj][m][0], v1 = acc[ai][bj][m][1];
                        if (seg == 1) {
#pragma unroll
                            for (int e = 0; e < 4; ++e) { v0[e] = gelu_tanh(v0[e]); v1[e] = gelu_tanh(v1[e]); }
                        } else if (seg >= 4) {
#pragma unroll
                            for (int e = 0; e < 4; ++e) { v0[e] = sigm(v0[e]); v1[e] = sigm(v1[e]); }
                        }
                        st8(base + (size_t)row * D + col0 + bj * 128, v0, v1);
                    }
                }
        }
    }
};

struct EpiStore {
    static constexpr bool PERM = true, AFTER_DRAIN = false;
    bf16_t* O; int ldc; float sc;
    __device__ __forceinline__ void operator()(const f32x4 (&acc)[2][2][4][2], const Unit& u, int wr, int wc, int fr, int fq) const {
        const int row0 = u.pm * 256 + wr * 64 + fr, col0 = u.pn * 256 + wc * 32 + 8 * fq;
#pragma unroll
        for (int ai = 0; ai < 2; ++ai)
#pragma unroll
            for (int m = 0; m < 4; ++m) {
                bf16_t* rp = O + (size_t)(row0 + ai * 128 + m * 16) * ldc + col0;
#pragma unroll
                for (int bj = 0; bj < 2; ++bj) st8(rp + bj * 128, acc[ai][bj][m][0] * sc, acc[ai][bj][m][1] * sc);
            }
    }
};

struct EpiGate {
    static constexpr bool PERM = true, AFTER_DRAIN = false;
    const bf16_t* G; const bf16_t* P; bf16_t* O; int MODE;
    __device__ __forceinline__ void operator()(const f32x4 (&acc)[2][2][4][2], const Unit& u, int wr, int wc, int fr, int fq) const {
        const int row0 = u.pm * 256 + wr * 64 + fr, col0 = u.pn * 256 + wc * 32 + 8 * fq;
#pragma unroll
        for (int ai = 0; ai < 2; ++ai)
#pragma unroll
            for (int m = 0; m < 4; ++m) {
                const size_t off = (size_t)(row0 + ai * 128 + m * 16) * D + col0;
#pragma unroll
                for (int bj = 0; bj < 2; ++bj) {
                    const u32x4 g = *(const u32x4*)(G + off + bj * 128);
                    f32x4 v0 = acc[ai][bj][m][0], v1 = acc[ai][bj][m][1];
                    v0 = v0 * (f32x4){bflo(g.x), bfhi(g.x), bflo(g.y), bfhi(g.y)}; v1 = v1 * (f32x4){bflo(g.z), bfhi(g.z), bflo(g.w), bfhi(g.w)};
                    if (MODE == 1) { const u32x4 p = *(const u32x4*)(P + off + bj * 128);
                        v0 = v0 + (f32x4){bflo(p.x), bfhi(p.x), bflo(p.y), bfhi(p.y)}; v1 = v1 + (f32x4){bflo(p.z), bfhi(p.z), bflo(p.w), bfhi(p.w)}; }
                    st8(O + off + bj * 128, v0, v1);
                }
            }
    }
};

struct EpiGate2 {
    static constexpr bool PERM = true, AFTER_DRAIN = false, HAS_MID = true;
    const bf16_t* GR; const bf16_t* GA; bf16_t* O;
    __device__ __forceinline__ void mid(f32x4 (&acc)[2][2][4][2], const Unit& u, int wr, int wc, int fr, int fq) const {
        int row0 = u.pm * 256 + wr * 64 + fr; const int col0 = u.pn * 256 + wc * 32 + 8 * fq;
        asm volatile("" : "+v"(row0));
#pragma unroll
        for (int ai = 0; ai < 2; ++ai)
#pragma unroll
            for (int m = 0; m < 4; ++m) {
                asm volatile("" ::: "memory");
                const size_t off = (size_t)(row0 + ai * 128 + m * 16) * D + col0;
#pragma unroll
                for (int bj = 0; bj < 2; ++bj) {
                    const u32x4 r = *(const u32x4*)(GR + off + bj * 128), g = *(const u32x4*)(GA + off + bj * 128);
                    const f32x4 r0 = (f32x4){bflo(r.x), bfhi(r.x), bflo(r.y), bfhi(r.y)}, r1 = (f32x4){bflo(r.z), bfhi(r.z), bflo(r.w), bfhi(r.w)};
                    f32x4 q0, q1;
                    q0[0] = __builtin_amdgcn_rcpf(fmaxf(bflo(g.x), 1e-30f)); q0[1] = __builtin_amdgcn_rcpf(fmaxf(bfhi(g.x), 1e-30f)); q0[2] = __builtin_amdgcn_rcpf(fmaxf(bflo(g.y), 1e-30f)); q0[3] = __builtin_amdgcn_rcpf(fmaxf(bfhi(g.y), 1e-30f));
                    q1[0] = __builtin_amdgcn_rcpf(fmaxf(bflo(g.z), 1e-30f)); q1[1] = __builtin_amdgcn_rcpf(fmaxf(bfhi(g.z), 1e-30f)); q1[2] = __builtin_amdgcn_rcpf(fmaxf(bflo(g.w), 1e-30f)); q1[3] = __builtin_amdgcn_rcpf(fmaxf(bfhi(g.w), 1e-30f));
                    acc[ai][bj][m][0] = acc[ai][bj][m][0] * (r0 * q0); acc[ai][bj][m][1] = acc[ai][bj][m][1] * (r1 * q1);
                }
            }
    }
    __device__ __forceinline__ void operator()(const f32x4 (&acc)[2][2][4][2], const Unit& u, int wr, int wc, int fr, int fq) const {
        const int row0 = u.pm * 256 + wr * 64 + fr, col0 = u.pn * 256 + wc * 32 + 8 * fq;
#pragma unroll
        for (int ai = 0; ai < 2; ++ai)
#pragma unroll
            for (int m = 0; m < 4; ++m) {
                const size_t off = (size_t)(row0 + ai * 128 + m * 16) * D + col0;
#pragma unroll
                for (int bj = 0; bj < 2; ++bj) {
                    const u32x4 g = *(const u32x4*)(GA + off + bj * 128);
                    st8(O + off + bj * 128, acc[ai][bj][m][0] * (f32x4){bflo(g.x), bfhi(g.x), bflo(g.y), bfhi(g.y)}, acc[ai][bj][m][1] * (f32x4){bflo(g.z), bfhi(g.z), bflo(g.w), bfhi(g.w)});
                }
            }
    }
};

struct EpiSwiglu {
    static constexpr bool PERM = true, AFTER_DRAIN = false;
    bf16_t* O;
    __device__ __forceinline__ void operator()(const f32x4 (&acc)[2][2][4][2], const Unit& u, int wr, int wc, int fr, int fq) const {
        const int row0 = u.pm * 256 + wr * 64 + fr, col0 = u.pn * 128 + wc * 32 + 8 * fq;
#pragma unroll
        for (int ai = 0; ai < 2; ++ai)
#pragma unroll
            for (int m = 0; m < 4; ++m) {
                f32x4 v0, v1;
#pragma unroll
                for (int e = 0; e < 4; ++e) { const float g0 = acc[ai][0][m][0][e], g1 = acc[ai][0][m][1][e];
                    v0[e] = g0 * sigm(g0) * acc[ai][1][m][0][e]; v1[e] = g1 * sigm(g1) * acc[ai][1][m][1][e]; }
                st8(O + (size_t)(row0 + ai * 128 + m * 16) * DFF + col0, v0, v1);
            }
    }
};

struct EpiResid {
    static constexpr bool PERM = false, AFTER_DRAIN = false;
    const float* base; float* out;
    __device__ __forceinline__ void operator()(const f32x4 (&acc)[2][2][4][2], const Unit& u, int wr, int wc, int fr, int fq) const {
        const int row0 = u.pm * 256 + wr * 64 + fr, col0 = u.pn * 256 + wc * 32 + 4 * fq;
#pragma unroll
        for (int ai = 0; ai < 2; ++ai)
#pragma unroll
            for (int m = 0; m < 4; ++m) {
                const size_t off = (size_t)(row0 + ai * 128 + m * 16) * D + col0;
#pragma unroll
                for (int bj = 0; bj < 2; ++bj)
#pragma unroll
                    for (int n = 0; n < 2; ++n) { const f32x4 b = *(const f32x4*)(base + off + bj * 128 + n * 16); *(f32x4*)(out + off + bj * 128 + n * 16) = b + acc[ai][bj][m][n]; }
            }
    }
};

struct EpiResidNorm {
    static constexpr bool PERM = false, AFTER_DRAIN = false;
    const float* base; float* out; bf16_t* xg; const float* gain; float* ssq;
    __device__ __forceinline__ void operator()(const f32x4 (&acc)[2][2][4][2], const Unit& u, int wr, int wc, int fr, int fq) const {
        const int row0 = u.pm * 256 + wr * 64 + fr, col0 = u.pn * 256 + wc * 32 + 4 * fq;
        f32x4 gv[2][2];
#pragma unroll
        for (int bj = 0; bj < 2; ++bj)
#pragma unroll
            for (int n = 0; n < 2; ++n) gv[bj][n] = *(const f32x4*)(gain + col0 + bj * 128 + n * 16);
#pragma unroll
        for (int ai = 0; ai < 2; ++ai)
#pragma unroll
            for (int m = 0; m < 4; ++m) {
                const int row = row0 + ai * 128 + m * 16; const size_t off = (size_t)row * D + col0;
                float s = 0.f;
#pragma unroll
                for (int bj = 0; bj < 2; ++bj)
#pragma unroll
                    for (int n = 0; n < 2; ++n) { const f32x4 b = *(const f32x4*)(base + off + bj * 128 + n * 16); const f32x4 o = b + acc[ai][bj][m][n];
                        *(f32x4*)(out + off + bj * 128 + n * 16) = o; s += (o[0] * o[0] + o[1] * o[1]) + (o[2] * o[2] + o[3] * o[3]);
                        const f32x4 y = o * gv[bj][n]; u32x2 w; w.x = pk2(y[0], y[1]); w.y = pk2(y[2], y[3]); *(u32x2*)(xg + off + bj * 128 + n * 16) = w; }
                s += __shfl_xor(s, 16); s += __shfl_xor(s, 32);
                if (fq == 0) atomicAdd(ssq + row, s);
            }
    }
};
struct EpiStoreRS {
    static constexpr bool PERM = true, AFTER_DRAIN = false;
    bf16_t* O; int ldc; float sc; const float* ssq;
    __device__ __forceinline__ void operator()(const f32x4 (&acc)[2][2][4][2], const Unit& u, int wr, int wc, int fr, int fq) const {
        const int row0 = u.pm * 256 + wr * 64 + fr, col0 = u.pn * 256 + wc * 32 + 8 * fq;
#pragma unroll
        for (int ai = 0; ai < 2; ++ai)
#pragma unroll
            for (int m = 0; m < 4; ++m) {
                const int row = row0 + ai * 128 + m * 16; const float rs = sc * (1.0f / sqrtf(ssq[row] * (1.f / D) + RMS_EPS));
                bf16_t* rp = O + (size_t)row * ldc + col0;
#pragma unroll
                for (int bj = 0; bj < 2; ++bj) st8(rp + bj * 128, acc[ai][bj][m][0] * rs, acc[ai][bj][m][1] * rs);
            }
    }
};
struct EpiSwigluRS {
    static constexpr bool PERM = true, AFTER_DRAIN = false;
    bf16_t* O; const float* ssq;
    __device__ __forceinline__ void operator()(const f32x4 (&acc)[2][2][4][2], const Unit& u, int wr, int wc, int fr, int fq) const {
        const int row0 = u.pm * 256 + wr * 64 + fr, col0 = u.pn * 128 + wc * 32 + 8 * fq;
#pragma unroll
        for (int ai = 0; ai < 2; ++ai)
#pragma unroll
            for (int m = 0; m < 4; ++m) {
                const int row = row0 + ai * 128 + m * 16; const float rs = 1.0f / sqrtf(ssq[row] * (1.f / D) + RMS_EPS);
                f32x4 v0, v1;
#pragma unroll
                for (int e = 0; e < 4; ++e) { const float g0 = acc[ai][0][m][0][e] * rs, g1 = acc[ai][0][m][1][e] * rs;
                    v0[e] = g0 * sigm(g0) * (acc[ai][1][m][0][e] * rs); v1[e] = g1 * sigm(g1) * (acc[ai][1][m][1][e] * rs); }
                st8(O + (size_t)row * DFF + col0, v0, v1);
            }
    }
};

__device__ __forceinline__ void tr_item(const float* W, int K, int N, bf16_t* WT, int row_off, int k0, int n0, LAS unsigned char* scr, int lane) {
    const int ng = lane & 15, kg = lane >> 4;
    const float* src = W + (size_t)(k0 + 4 * kg) * N + n0 + 4 * ng;
    f32x4 v[4][4];
#pragma unroll
    for (int s = 0; s < 4; ++s)
#pragma unroll
        for (int j = 0; j < 4; ++j) v[s][j] = *(const f32x4*)(src + (size_t)(16 * s + j) * N);
#pragma unroll
    for (int s = 0; s < 4; ++s)
#pragma unroll
        for (int e = 0; e < 4; ++e) { u32x2 o; o.x = pk2(v[s][0][e], v[s][1][e]); o.y = pk2(v[s][2][e], v[s][3][e]);
            *(LAS u32x2*)(scr + (4 * ng + e) * 128 + (((2 * s + (kg >> 1)) ^ (ng & 7)) << 4) + (kg & 1) * 8) = o; }
    asm volatile("s_waitcnt lgkmcnt(0)" ::: "memory");
#pragma unroll
    for (int i = 0; i < 8; ++i) { const int n = 8 * i + (lane >> 3), c = lane & 7;
        const u32x4 o = *(const LAS u32x4*)(scr + n * 128 + ((c ^ ((n >> 2) & 7)) << 4));
        *(u32x4*)(WT + (size_t)(row_off + n0 + n) * K + k0 + 8 * c) = o; }
    asm volatile("s_waitcnt lgkmcnt(0)" ::: "memory");
}
template <class RowMap>
__device__ __forceinline__ int tr_matrix(const float* W, int K, int N, bf16_t* WT, RowMap rm, LAS float* scr, int lane_, int gw, int NGW, int it0) {
    int lane = lane_; asm volatile("" : "+v"(lane));
    const int nblk = N / 64, nitems = (K / 64) * nblk;
    int first = ((gw - it0) % NGW + NGW) % NGW;
    for (int it = first; it < nitems; it += NGW) { const int kb = it / nblk, nb = it % nblk; tr_item(W, K, N, WT, rm(nb * 64), kb * 64, nb * 64, (LAS unsigned char*)scr, lane); }
    return (it0 + nitems) % NGW;
}
struct RmId { __device__ __forceinline__ int operator()(int) const { return 0; } };
struct RmWin { __device__ __forceinline__ int operator()(int n0) const { const int seg = n0 >> 11; const int os = seg < 4 ? seg : (seg == 4 ? 6 : seg - 1); return (os - seg) * 2048; } };
struct RmGu { int up; __device__ __forceinline__ int operator()(int n0) const { const int c = n0; return 256 * (c >> 7) + (c & 127) + 128 * up - c; } };

template <bool OUT32>
__device__ __forceinline__ void norm_row(const float* xrow, const f32x4 (&g)[8], void* orow, int lane) {
    const f32x4* xr = (const f32x4*)xrow + lane;
    f32x4 v[8]; float s = 0.f;
#pragma unroll
    for (int j = 0; j < 8; ++j) { v[j] = OUT32 ? __builtin_nontemporal_load(xr + 64 * j) : xr[64 * j]; s += (v[j][0] * v[j][0] + v[j][1] * v[j][1]) + (v[j][2] * v[j][2] + v[j][3] * v[j][3]); }
    const float rs = 1.0f / sqrtf(wave_sum(s) * (1.f / D) + RMS_EPS);
    if (OUT32) { f32x4* o = (f32x4*)orow + lane;
#pragma unroll
        for (int j = 0; j < 8; ++j) __builtin_nontemporal_store(v[j] * rs * g[j], o + 64 * j);
    } else { u32x2* o = (u32x2*)orow + lane;
#pragma unroll
        for (int j = 0; j < 8; ++j) { const f32x4 y = v[j] * rs * g[j]; u32x2 w; w.x = pk2(y[0], y[1]); w.y = pk2(y[2], y[3]); o[64 * j] = w; }
    }
}
template <bool OUT32>
__device__ __forceinline__ void norm_rows(const float* src, const float* gain, void* dst, int nrows, int gw, int NGW, int lane_) {
    int lane = lane_; asm volatile("" : "+v"(lane));
    f32x4 g[8];
#pragma unroll
    for (int j = 0; j < 8; ++j) g[j] = ((const f32x4*)gain)[lane + 64 * j];
    for (int r = gw; r < nrows; r += NGW) norm_row<OUT32>(src + (size_t)r * D, g, OUT32 ? (void*)((float*)dst + (size_t)r * D) : (void*)((bf16_t*)dst + (size_t)r * D), lane);
}

constexpr int ATT_KB = 0, ATT_VB = 49152, ATT_KM = 98304;
template <bool MOBA>
__device__ __forceinline__ void attn_unit(LAS unsigned char* lds, const bf16_t* Qp, int qpitch, const bf16_t* Kp, int kpitch, const bf16_t* VTp, int vtpitch,
                                          bf16_t* Op, int opitch, int ntiles, int j, const float* kmean_bh, int nostore = 0) {
    int tid_l = threadIdx.x; asm volatile("" : "+v"(tid_l));
    const int tid = tid_l, lane = tid & 63, w = __builtin_amdgcn_readfirstlane(tid >> 6), ql = lane & 31, h2 = lane >> 5;
#define ATT_LOAD(i, b) do { _Pragma("unroll") for (int _i = 0; _i < 2; ++_i) { \
        __builtin_amdgcn_global_load_lds((const unsigned*)((const char*)Kp + (size_t)(64 * (i)) * kpitch * 2 + kg[_i]), (LAS unsigned*)(lds + ATT_KB + (b) * 16384 + (2 * w + _i) * 1024), 16, 0, 0); \
        __builtin_amdgcn_global_load_lds((const unsigned*)((const char*)VTp + (size_t)(64 * (i)) * 2 + vg[_i]), (LAS unsigned*)(lds + ATT_VB + (b) * 16384 + (2 * w + _i) * 1024), 16, 0, 0); } } while (0)
#define ATT_WAITBAR(n) do { asm volatile("s_waitcnt vmcnt(" #n ") lgkmcnt(0)" ::: "memory"); __builtin_amdgcn_s_barrier(); asm volatile("" ::: "memory"); } while (0)
    {
        unsigned kg[2], vg[2];
#pragma unroll
    for (int i = 0; i < 2; ++i) { const int pp = (2 * w + i) * 64 + lane; const int kr = pp >> 4, kc = (pp & 15) ^ (kr & 15), vr = pp >> 3, vc = (pp & 7) ^ ((vr >> 1) & 7);
        kg[i] = (unsigned)(kr * kpitch + kc * 8) * 2u; vg[i] = (unsigned)(vr * vtpitch + vc * 8) * 2u; }
    asm volatile("s_waitcnt vmcnt(0)" ::: "memory");
    ATT_LOAD(0, 0);
    if (ntiles > 1) ATT_LOAD(1, 1);
    }
    bf16x8 qf[8];
    { const bf16_t* qr = Qp + (size_t)(32 * w + ql) * qpitch + 8 * h2;
#pragma unroll
      for (int ks = 0; ks < 8; ++ks) qf[ks] = *(const bf16x8*)(qr + 16 * ks); }
    unsigned selmask = 0xffffffffu;
    if (MOBA) {
        if (j > 3) {
            LAS float* KM = (LAS float*)(lds + ATT_KM);
            for (int i = tid; i < j * 128; i += 512) KM[i] = kmean_bh[(size_t)(i >> 7) * D + (i & 127)];
            __syncthreads();
            float g[15];
#pragma unroll
            for (int kb = 0; kb < 15; ++kb) {
                float s = -INFINITY;
                if (kb < j) {
                    s = 0.f;
#pragma unroll
                    for (int ks = 0; ks < 8; ++ks) {
                        const f32x4 k0 = *(const LAS f32x4*)(KM + kb * 128 + 16 * ks + 8 * h2), k1 = *(const LAS f32x4*)(KM + kb * 128 + 16 * ks + 8 * h2 + 4);
                        const u32x4 qq = __builtin_bit_cast(u32x4, qf[ks]);
                        s += bflo(qq.x) * k0[0] + bfhi(qq.x) * k0[1] + bflo(qq.y) * k0[2] + bfhi(qq.y) * k0[3] + bflo(qq.z) * k1[0] + bfhi(qq.z) * k1[1] + bflo(qq.w) * k1[2] + bfhi(qq.w) * k1[3];
                    }
                    s += __shfl_xor(s, 32);
                }
                g[kb] = s;
            }
            selmask = 0u;
#pragma unroll
            for (int kb = 0; kb < 15; ++kb) {
                int cnt = 0;
#pragma unroll
                for (int k2 = 0; k2 < 15; ++k2) if (k2 != kb) cnt += (g[k2] > g[kb] || (g[k2] == g[kb] && k2 < kb)) ? 1 : 0;
                if (kb < j && cnt < 3) selmask |= (1u << kb);
            }
        }
    }
    const int kkey = (ql & 19) | ((ql & 4) << 1) | ((ql & 8) >> 1);
    const unsigned kbase = (unsigned)(kkey * 256 + ((h2 ^ (kkey & 15)) << 4));
    const unsigned vbase = (unsigned)(ql * 128 + ((h2 ^ ((ql >> 1) & 7)) << 4));
    int lane_s = lane; asm volatile("" : "+v"(lane_s));
    unsigned kg[2], vg[2];
#pragma unroll
    for (int i = 0; i < 2; ++i) { const int pp = (2 * w + i) * 64 + lane_s; const int kr = pp >> 4, kc = (pp & 15) ^ (kr & 15), vr = pp >> 3, vc = (pp & 7) ^ ((vr >> 1) & 7);
        kg[i] = (unsigned)(kr * kpitch + kc * 8) * 2u; vg[i] = (unsigned)(vr * vtpitch + vc * 8) * 2u; }
    f32x16 ot[4];
#pragma unroll
    for (int dt = 0; dt < 4; ++dt)
#pragma unroll
        for (int r = 0; r < 16; ++r) ot[dt][r] = 0.f;
    float mrow = NEGBIG, lsum = 0.f;
    ATT_WAITBAR(0);
    int b = 0;
#pragma unroll 1
    for (int i = 0; i < ntiles; ++i) {
        const int b2 = (b == 0) ? 2 : b - 1;
        if (i + 2 < ntiles) ATT_LOAD(i + 2, b2);
        bool need = true, selme = true; int kt = 0; bool own = false;
        if (MOBA) {
            if (i < 4 * j) { selme = (selmask >> (i >> 2)) & 1u; need = __builtin_amdgcn_ballot_w64(selme) != 0ull; }
            else { own = true; kt = i - 4 * j; need = kt <= (w >> 1); }
        }
        if (need) {
            const LAS unsigned char* kb_ = lds + ATT_KB + b * 16384;
            const LAS unsigned char* vb_ = lds + ATT_VB + b * 16384;
            f32x16 st[2];
            bf16x8 ka[8];
#pragma unroll
            for (int ks = 0; ks < 8; ++ks) ka[ks] = *(const LAS bf16x8*)(kb_ + (kbase ^ (unsigned)(ks << 5)));
            bf16x8 va[2][4];
#pragma unroll
            for (int dt = 0; dt < 4; ++dt) va[0][dt] = *(const LAS bf16x8*)(vb_ + dt * 4096 + vbase);
#pragma unroll
            for (int rt = 0; rt < 2; ++rt)
#pragma unroll
                for (int r = 0; r < 16; ++r) st[rt][r] = 0.f;
            __builtin_amdgcn_sched_barrier(0);
            __builtin_amdgcn_s_setprio(1);
#pragma unroll
            for (int ks = 0; ks < 8; ++ks) { st[0] = __builtin_amdgcn_mfma_f32_32x32x16_bf16(ka[ks], qf[ks], st[0], 0, 0, 0);
                ka[ks] = *(const LAS bf16x8*)(kb_ + 8192 + (kbase ^ (unsigned)(ks << 5))); __builtin_amdgcn_sched_barrier(0); }
#pragma unroll
            for (int ks = 0; ks < 8; ++ks) st[1] = __builtin_amdgcn_mfma_f32_32x32x16_bf16(ka[ks], qf[ks], st[1], 0, 0, 0);
            __builtin_amdgcn_s_setprio(0);
            if (MOBA) {
                if (own && 64 * kt + 63 > 32 * w) {
                    const int qloc = 32 * w + ql;
#pragma unroll
                    for (int rt = 0; rt < 2; ++rt)
#pragma unroll
                        for (int r = 0; r < 16; ++r) { const int key = 64 * kt + 32 * rt + 16 * (r >> 3) + 8 * h2 + (r & 7); if (key > qloc) st[rt][r] = NEGBIG; }
                }
            }
            float mx = st[0][0];
#pragma unroll
            for (int rt = 0; rt < 2; ++rt)
#pragma unroll
                for (int r = 0; r < 16; ++r) mx = fmaxf(mx, st[rt][r]);
            if (MOBA) mx = selme ? mx : NEGBIG;
            mx = fmaxf(mx, __shfl_xor(mx, 32));
            if (__builtin_amdgcn_ballot_w64(mx > mrow + 8.0f) != 0ull) {
                const float mnew = fmaxf(mrow, mx), alpha = __builtin_amdgcn_exp2f(mrow - mnew);
                mrow = mnew; lsum *= alpha;
#pragma unroll
                for (int dt = 0; dt < 4; ++dt)
#pragma unroll
                    for (int r = 0; r < 16; ++r) ot[dt][r] *= alpha;
            }
            const float msub = (MOBA && !selme) ? 1e30f : mrow;
            float ps = 0.f;
#pragma unroll
            for (int rt = 0; rt < 2; ++rt)
#pragma unroll
                for (int r = 0; r < 16; ++r) { const float p = __builtin_amdgcn_exp2f(st[rt][r] - msub); st[rt][r] = p; ps += p; }
            lsum += ps;
#pragma unroll
            for (int kk = 0; kk < 4; ++kk) {
                const int rt = kk >> 1, s = kk & 1;
                u32x4 pw; pw.x = pk2(st[rt][8 * s + 0], st[rt][8 * s + 1]); pw.y = pk2(st[rt][8 * s + 2], st[rt][8 * s + 3]); pw.z = pk2(st[rt][8 * s + 4], st[rt][8 * s + 5]); pw.w = pk2(st[rt][8 * s + 6], st[rt][8 * s + 7]);
                const bf16x8 pb = __builtin_bit_cast(bf16x8, pw);
                if (kk < 3) {
#pragma unroll
                    for (int dt = 0; dt < 4; ++dt) va[(kk + 1) & 1][dt] = *(const LAS bf16x8*)(vb_ + dt * 4096 + (vbase ^ (unsigned)((kk + 1) << 5)));
                }
                __builtin_amdgcn_s_setprio(1);
#pragma unroll
                for (int dt = 0; dt < 4; ++dt) ot[dt] = __builtin_amdgcn_mfma_f32_32x32x16_bf16(va[kk & 1][dt], pb, ot[dt], 0, 0, 0);
                __builtin_amdgcn_s_setprio(0);
                __builtin_amdgcn_sched_barrier(0);
            }
        }
        if (i + 2 < ntiles) ATT_WAITBAR(4); else ATT_WAITBAR(0);
        b = (b == 2) ? 0 : b + 1;
    }
#undef ATT_LOAD
#undef ATT_WAITBAR
    lsum += __shfl_xor(lsum, 32);
    const float inv = 1.f / lsum;
    if (nostore && inv != 1234.5f) return;
    int lq = ql; asm volatile("" : "+v"(lq));
    bf16_t* obase = Op + (unsigned)((32 * w + lq) * opitch + 8 * h2);
#pragma unroll
    for (int dt = 0; dt < 4; ++dt)
#pragma unroll
        for (int gp = 0; gp < 2; ++gp) {
            const int g0 = 2 * gp, g1 = 2 * gp + 1;
            unsigned ax = pk2(ot[dt][4 * g0] * inv, ot[dt][4 * g0 + 1] * inv), ay = pk2(ot[dt][4 * g0 + 2] * inv, ot[dt][4 * g0 + 3] * inv);
            unsigned bx_ = pk2(ot[dt][4 * g1] * inv, ot[dt][4 * g1 + 1] * inv), by_ = pk2(ot[dt][4 * g1 + 2] * inv, ot[dt][4 * g1 + 3] * inv);
            { auto r = __builtin_amdgcn_permlane32_swap(ax, bx_, false, false); ax = r[0]; bx_ = r[1]; }
            { auto r = __builtin_amdgcn_permlane32_swap(ay, by_, false, false); ay = r[0]; by_ = r[1]; }
            u32x4 o; o.x = ax; o.y = ay; o.z = bx_; o.w = by_;
            *(u32x4*)(obase + 32 * dt + 16 * gp) = o;
        }
}

__device__ __forceinline__ void conv_prepass(const bf16_t* XR, bf16_t* Y, const float* conv_w, const float* conv_b, int gt, int GT) {
    const int cg = gt & 255, chb = 8 * cg;
    float cw[4][8], cb[8];
#pragma unroll
    for (int e = 0; e < 8; ++e) { cb[e] = conv_b[chb + e];
#pragma unroll
        for (int k = 0; k < 4; ++k) cw[k][e] = conv_w[k * D + chb + e]; }
#pragma unroll 1
    for (int item = gt; item < (T / 8) * 256; item += GT) {
        const int t0 = (item >> 8) * 8, s0 = t0 & (SEQ - 1);
        u32x4 x[11];
#pragma unroll
        for (int i = 0; i < 11; ++i) x[i] = (i >= 3 || s0 != 0) ? *(const u32x4*)(XR + (size_t)(t0 - 3 + i) * D + chb) : (u32x4){0u, 0u, 0u, 0u};
#pragma unroll
        for (int i = 0; i < 8; ++i) {
            float y[8];
#pragma unroll
            for (int e = 0; e < 8; ++e) y[e] = cb[e];
#pragma unroll
            for (int k = 0; k < 4; ++k) { const u32x4 v = x[i + k];
                y[0] += cw[k][0] * bflo(v.x); y[1] += cw[k][1] * bfhi(v.x); y[2] += cw[k][2] * bflo(v.y); y[3] += cw[k][3] * bfhi(v.y);
                y[4] += cw[k][4] * bflo(v.z); y[5] += cw[k][5] * bfhi(v.z); y[6] += cw[k][6] * bflo(v.w); y[7] += cw[k][7] * bfhi(v.w); }
            u32x4 o; o.x = pk2(y[0], y[1]); o.y = pk2(y[2], y[3]); o.z = pk2(y[4], y[5]); o.w = pk2(y[6], y[7]);
            *(u32x4*)(Y + (size_t)(t0 + i) * D + chb) = o;
        }
    }
}
constexpr int RN_AU = 0, RN_HS = 16384;
struct RnnP { const bf16_t* Y; const bf16_t* GY; bf16_t* GYO; const bf16_t* Wa_t; const bf16_t* Wi_t; const float* b_a; const float* b_i; const float* lam; };
__device__ __forceinline__ void rnn_unit(LAS unsigned char* lds, const RnnP& P, int b, int n, int jq) {
    int tid_l = threadIdx.x; asm volatile("" : "+v"(tid_l));
    const int tid = tid_l, lane = tid & 63, w = __builtin_amdgcn_readfirstlane(tid >> 6);
    const int rt = w >> 1, ct = w & 1, l15 = lane & 15, l4 = lane >> 4;
    bf16x8 bfa[4], bfi[4];
    { const size_t wo = ((size_t)n * 128 + 32 * jq + 16 * ct + l15) * 128 + 8 * l4;
#pragma unroll
      for (int ks = 0; ks < 4; ++ks) { bfa[ks] = *(const bf16x8*)(P.Wa_t + wo + 32 * ks); bfi[ks] = *(const bf16x8*)(P.Wi_t + wo + 32 * ks); } }
    const int chj = n * 128 + 32 * jq + 16 * ct + l15;
    const float ba = P.b_a[chj], bi = P.b_i[chj];
    const float sp8 = 8.f * 1.4426950408889634f * log1pf(expf(-P.lam[chj]));
    float hstate = 0.f;
    const size_t rowbase = (size_t)b * SEQ;
    const bf16_t* yap = P.Y + (rowbase + 16 * rt + l15) * D + n * 128 + 8 * l4;
    const bf16_t* yvp = P.Y + (rowbase + 16 * rt + 4 * l4) * D + chj;
    const size_t gyo0 = (rowbase + (tid >> 3)) * D + n * 128 + 32 * jq + 4 * (tid & 7);
#define RN_BAR() do { asm volatile("s_waitcnt lgkmcnt(0)" ::: "memory"); __builtin_amdgcn_s_barrier(); asm volatile("" ::: "memory"); } while (0)
#define RN_LOAD(ya, yv, gy, t0) do { _Pragma("unroll") for (int ks = 0; ks < 4; ++ks) ya[ks] = *(const bf16x8*)(yap + (size_t)(t0) * D + 32 * ks); \
        _Pragma("unroll") for (int r = 0; r < 4; ++r) yv[r] = *(const unsigned short*)(yvp + (size_t)((t0) + r) * D); gy = *(const u32x2*)(P.GY + gyo0 + (size_t)(t0) * D); } while (0)
    bf16x8 yac[4], yan[4]; unsigned short yvc[4], yvn[4]; u32x2 gyc, gyn;
    RN_LOAD(yac, yvc, gyc, 0);
#pragma unroll
    for (int ks = 0; ks < 4; ++ks) yan[ks] = yac[ks];
#pragma unroll
    for (int r = 0; r < 4; ++r) yvn[r] = yvc[r];
    gyn = gyc;
#pragma unroll 1
    for (int st = 0; st < SEQ / 64; ++st) {
        const int t0 = st * 64;
        if (st + 1 < SEQ / 64) RN_LOAD(yan, yvn, gyn, t0 + 64);
        {
            f32x4 ar = (f32x4){0.f, 0.f, 0.f, 0.f}, ai = ar;
#pragma unroll
            for (int ks = 0; ks < 4; ++ks) { ar = __builtin_amdgcn_mfma_f32_16x16x32_bf16(yac[ks], bfa[ks], ar, 0, 0, 0); ai = __builtin_amdgcn_mfma_f32_16x16x32_bf16(yac[ks], bfi[ks], ai, 0, 0, 0); }
#pragma unroll
            for (int r = 0; r < 4; ++r) {
                const int tl = 16 * rt + 4 * l4 + r, jl = 16 * ct + l15;
                const float y = __builtin_bit_cast(float, (unsigned)yvc[r] << 16);
                const float rg = sigm(ar[r] + ba), ig = sigm(ai[r] + bi);
                const float log_a = -sp8 * rg;
                const float a = __builtin_amdgcn_exp2f(log_a), mult = __builtin_amdgcn_sqrtf(fmaxf(1.f - a * a, 0.f));
                f32x2 au; au.x = a; au.y = mult * (ig * y);
                *(LAS f32x2*)(lds + RN_AU + (tl * 32 + jl) * 8) = au;
            }
        }
        RN_BAR();
        if (tid < 32) {
            float h = hstate;
            f32x2 au[16], aun[16];
#pragma unroll
            for (int t = 0; t < 16; ++t) au[t] = *(const LAS f32x2*)(lds + RN_AU + (t * 32 + tid) * 8);
#pragma unroll
            for (int c = 0; c < 4; ++c) {
                if (c < 3) {
#pragma unroll
                    for (int t = 0; t < 16; ++t) aun[t] = *(const LAS f32x2*)(lds + RN_AU + ((16 * (c + 1) + t) * 32 + tid) * 8);
                }
                float hv[16];
#pragma unroll
                for (int t = 0; t < 16; ++t) { h = au[t].x * h + au[t].y; hv[t] = h; }
#pragma unroll
                for (int t = 0; t < 16; ++t) *(LAS float*)(lds + RN_HS + ((16 * c + t) * 32 + tid) * 4) = hv[t];
#pragma unroll
                for (int t = 0; t < 16; ++t) au[t] = aun[t];
            }
            hstate = h;
        }
        RN_BAR();
        {
            const f32x4 h4 = *(const LAS f32x4*)(lds + RN_HS + ((tid >> 3) * 32 + 4 * (tid & 7)) * 4);
            u32x2 o; o.x = pk2(bflo(gyc.x) * h4[0], bfhi(gyc.x) * h4[1]); o.y = pk2(bflo(gyc.y) * h4[2], bfhi(gyc.y) * h4[3]);
            *(u32x2*)(P.GYO + gyo0 + (size_t)t0 * D) = o;
        }
#pragma unroll
        for (int ks = 0; ks < 4; ++ks) yac[ks] = yan[ks];
#pragma unroll
        for (int r = 0; r < 4; ++r) yvc[r] = yvn[r];
        gyc = gyn;
    }
#undef RN_BAR
#undef RN_LOAD
    __syncthreads();
}

#define XB_TMO      128
#define XB_XCNT(j)  (256  + 64 * (j))
#define XB_XSUB(j)  (1280 + 64 * (j))
#define XB_XGEN(j)  (2304 + 64 * (j))
#define XB_TOP      3328
#define XB_TOPGEN   3392
#define XCD_BAR_WORDS 3456
#define XB_SPIN_CAP (1u << 18)

__device__ __forceinline__ unsigned xb_ld(unsigned* p)              { return __hip_atomic_load(p, __ATOMIC_RELAXED, __HIP_MEMORY_SCOPE_AGENT); }
__device__ __forceinline__ unsigned xb_add(unsigned* p, unsigned v) { return __hip_atomic_fetch_add(p, v, __ATOMIC_RELAXED, __HIP_MEMORY_SCOPE_AGENT); }
__device__ __forceinline__ unsigned xb_xcc_id() { return (unsigned)__builtin_amdgcn_s_getreg((3 << 11) | 20) & 0xFu; }
#define XB_SPIN(cond, bar) do { unsigned _sp = 0; while (cond) { __builtin_amdgcn_s_sleep(1); \
    if ((++_sp & 255u) == 0u) { if (xb_ld(&(bar)[XB_TMO])) break; if (_sp > XB_SPIN_CAP) { atomicAdd(&(bar)[XB_TMO], 1u); break; } } } } while (0)

struct XcdBarrier {
    unsigned* bar; unsigned x;
    volatile LAS unsigned* st;
};

__device__ __forceinline__ XcdBarrier xcd_barrier_post(unsigned* bar, volatile LAS unsigned* st) {
    XcdBarrier b; b.bar = bar; b.x = xb_xcc_id(); b.st = st;
    if (threadIdx.x == 0) (void)xb_add(&bar[XB_XCNT(b.x)], 1u);
    return b;
}
__device__ __forceinline__ void xcd_barrier_complete(unsigned* bar, unsigned x, unsigned& nloc, unsigned& nx) {
    const unsigned G = gridDim.x * gridDim.y * gridDim.z;
    unsigned sum, cnt, mine, sp = 0u;
    for (;;) {
        sum = 0u; cnt = 0u; mine = 0u;
#pragma unroll
        for (unsigned j = 0; j < 16; ++j) { const unsigned c = xb_ld(&bar[XB_XCNT(j)]); sum += c; cnt += (c > 0u) ? 1u : 0u; mine = (j == x) ? c : mine; }
        if (sum == G) break;
        __builtin_amdgcn_s_sleep(1);
        if ((++sp & 255u) == 0u) { if (xb_ld(&bar[XB_TMO])) break; if (sp > XB_SPIN_CAP) { atomicAdd(&bar[XB_TMO], 1u); break; } }
    }
    nloc = mine > 0u ? mine : 1u; nx = cnt > 0u ? cnt : 1u;
}

__device__ __forceinline__ void xcd_barrier(const XcdBarrier& b) {
    asm volatile("s_waitcnt vmcnt(0)" ::: "memory");
    __syncthreads();
    if (threadIdx.x == 0) {
        unsigned* bar = b.bar;
        __builtin_amdgcn_s_waitcnt(0);
        unsigned nloc = b.st[0], nx = b.st[1];
        if (nloc == 0u) { xcd_barrier_complete(bar, b.x, nloc, nx); b.st[0] = nloc; b.st[1] = nx; }
        const unsigned old = xb_add(&bar[XB_XSUB(b.x)], 1u);
        const unsigned gen = old / nloc;
        if (old + 1u == (gen + 1u) * nloc) {
            __builtin_amdgcn_fence(__ATOMIC_RELEASE, "agent");
            asm volatile("s_waitcnt vmcnt(0)" ::: "memory");
            const unsigned og = xb_add(&bar[XB_TOP], 1u);
            const unsigned tg = og / nx;
            if (og + 1u == (tg + 1u) * nx) xb_add(&bar[XB_TOPGEN], 1u);
            else XB_SPIN(xb_ld(&bar[XB_TOPGEN]) == tg, bar);
            __builtin_amdgcn_fence(__ATOMIC_ACQUIRE, "agent");
            xb_add(&bar[XB_XGEN(b.x)], 1u);
            asm volatile("s_waitcnt vmcnt(0)" ::: "memory");
        } else {
            XB_SPIN(xb_ld(&bar[XB_XGEN(b.x)]) == gen, bar);
            __builtin_amdgcn_fence(__ATOMIC_ACQUIRE, "agent");
            asm volatile("s_waitcnt vmcnt(0)" ::: "memory");
        }
    }
    __syncthreads();
}

struct Args {
    const float* x; const float* mem; const int* pos; const float* norm_mix_g; const float* w_in; const float* conv_w; const float* conv_b;
    const float* lru_w_a; const float* lru_b_a; const float* lru_w_i; const float* lru_b_i; const float* lru_lambda;
    const float* w_rnn_proj; const float* w_attn_proj; const float* w_mix_out; const float* norm_xq_g; const float* norm_mem_g;
    const float* w_xq; const float* w_xkv; const float* w_xo; const float* norm_ffn_g; const float* w_ffn_gate; const float* w_ffn_up; const float* w_ffn_down; const float* norm_final_g;
    float* out; unsigned char* ws; int ph_lo, ph_hi;
};
constexpr int NPHASE = 13;
#ifndef WGM_WIDE
#define WGM_WIDE 4
#endif
#ifndef WGM_NARROW
#define WGM_NARROW 2
#endif
#ifndef WGM_VT
#define WGM_VT 4
#endif
#ifndef MK_PER_PHASE
#define MK_PER_PHASE 0
#endif

__device__ __forceinline__ unsigned long long ldarg(unsigned off) {
    unsigned long long kp = (unsigned long long)__builtin_amdgcn_kernarg_segment_ptr(), v;
    asm volatile("s_load_dwordx2 %0, %1, %2\n\ts_waitcnt lgkmcnt(0)" : "=s"(v) : "s"(kp), "i"(off) : "memory");
    return v;
}
#define ARGF(field) ((const float*)ldarg((unsigned)__builtin_offsetof(Args, field)))
#define ARGI(field) ((const int*)ldarg((unsigned)__builtin_offsetof(Args, field)))


__global__ void __launch_bounds__(512, 2) fwd(Args a) {
    extern __shared__ __attribute__((aligned(16))) unsigned char lds_raw[];
    LAS unsigned char* lds = (LAS unsigned char*)lds_raw;
    __builtin_assume(__builtin_amdgcn_workitem_id_y() == 0); __builtin_assume(__builtin_amdgcn_workitem_id_z() == 0);
    cg::grid_group grid = cg::this_grid();
    const int tid = threadIdx.x, lane = tid & 63, wave = __builtin_amdgcn_readfirstlane(tid >> 6);
    const int G = gridDim.x, bx = blockIdx.x;
    const int vcu = (G % 8 == 0) ? (bx % 8) * (G / 8) + bx / 8 : bx;
    const int gw = vcu * 8 + wave, NGW = G * 8;
    unsigned char* ws = a.ws;
    bf16_t* Win_t = (bf16_t*)(ws + WS_WIN); bf16_t* Wgu_t = (bf16_t*)(ws + WS_WGU);
    bf16_t* Wa_t = (bf16_t*)(ws + WS_WGATE); bf16_t* Wi_t = (bf16_t*)(ws + WS_WGATE + 512 * 1024);
    bf16_t* Wrnn_t = (bf16_t*)(ws + WS_WRNN); bf16_t* Wattn_t = (bf16_t*)(ws + WS_WATTN); bf16_t* Wmix_t = (bf16_t*)(ws + WS_WMIX);
    bf16_t* Wxq_t = (bf16_t*)(ws + WS_WXQ); bf16_t* Wxkv_t = (bf16_t*)(ws + WS_WXKV); bf16_t* Wxo_t = (bf16_t*)(ws + WS_WXO); bf16_t* Wdown_t = (bf16_t*)(ws + WS_WDOWN);
    bf16_t* K2 = (bf16_t*)(ws + WS_K2); bf16_t* V2T = (bf16_t*)(ws + WS_V2T);
    float* KMEAN = (float*)(ws + WS_KMEAN); float2* CS = (float2*)(ws + WS_CS);
    bf16_t* MEMN = (bf16_t*)(ws + WS_MEMN); bf16_t* H = (bf16_t*)(ws + WS_H);
    bf16_t* XR = (bf16_t*)(ws + WS_XR); bf16_t* GY = (bf16_t*)(ws + WS_GY); bf16_t* Qb = (bf16_t*)(ws + WS_Q); bf16_t* Kb = (bf16_t*)(ws + WS_K); bf16_t* VT = (bf16_t*)(ws + WS_VT);
    bf16_t* ACT = (bf16_t*)(ws + WS_ACT); bf16_t* Q2 = (bf16_t*)(ws + WS_Q2); bf16_t* O2 = (bf16_t*)(ws + WS_O2); bf16_t* T1 = (bf16_t*)(ws + WS_T1);
    bf16_t* SGR = (bf16_t*)a.out; bf16_t* SGA = SGR + SEG_ELEMS;
    float* SSQ1 = (float*)ws; float* SSQ2 = SSQ1 + T;
    const int lo = a.ph_lo, hi = a.ph_hi;
#ifndef PHMASK
#define PHMASK 0xffff
#endif
#define IN(k) (((PHMASK >> (k)) & 1) && lo <= (k) && (k) < hi)
#define LANE_NOW() ({ int t_ = threadIdx.x; asm volatile("" : "+v"(t_)); t_ & 63; })
#define XBAR() do { XcdBarrier xb_; xb_.bar = (unsigned*)(ws + WS_XBAR); xb_.x = xb_xcc_id(); xb_.st = (volatile LAS unsigned*)(lds + LDS_XB_ST); xcd_barrier(xb_); } while (0)
#if MK_PER_PHASE
#define SEAM(k) do { } while (0)
#else
#define SEAM(k) do { if (IN(k) && IN((k) + 1)) { if ((k) == 0) { grid.sync(); (void)xcd_barrier_post((unsigned*)(ws + WS_XBAR), (volatile LAS unsigned*)(lds + LDS_XB_ST)); } else XBAR(); } } while (0)
#endif
#ifndef DUP_PHASE
#define DUP_PHASE -1
#endif
#ifndef DUP_PART
#define DUP_PART 7
#endif
#define REPS(k) ((DUP_PHASE == (k)) ? 2 : 1)
#define REPLOOP(k) for (int rep = 0; rep < REPS(k); ++rep)
#define REPSYNC() do { if (rep) XBAR(); } while (0)
    LAS float* scr = (LAS float*)(lds + wave * 16384);
    if (tid < 2) ((LAS unsigned*)(lds + LDS_XB_ST))[tid] = 0u;
    __syncthreads();

    if (IN(0)) REPLOOP(0) { REPSYNC();
        int it = 0;
        it = tr_matrix(ARGF(w_in), D, 14336, Win_t, RmWin{}, scr, lane, gw, NGW, it);
        it = tr_matrix(ARGF(w_rnn_proj), D, D, Wrnn_t, RmId{}, scr, lane, gw, NGW, it);
        it = tr_matrix(ARGF(w_attn_proj), D, D, Wattn_t, RmId{}, scr, lane, gw, NGW, it);
        it = tr_matrix(ARGF(w_mix_out), D, D, Wmix_t, RmId{}, scr, lane, gw, NGW, it);
        it = tr_matrix(ARGF(w_xq), D, DMEM, Wxq_t, RmId{}, scr, lane, gw, NGW, it);
        it = tr_matrix(ARGF(w_xkv), D, 2 * DMEM, Wxkv_t, RmId{}, scr, lane, gw, NGW, it);
        it = tr_matrix(ARGF(w_xo), DMEM, D, Wxo_t, RmId{}, scr, lane, gw, NGW, it);
        for (int blk = 0; blk < 16; ++blk) {
            it = tr_matrix(ARGF(lru_w_a) + blk * 16384, 128, 128, Wa_t + blk * 16384, RmId{}, scr, lane, gw, NGW, it);
            it = tr_matrix(ARGF(lru_w_i) + blk * 16384, 128, 128, Wi_t + blk * 16384, RmId{}, scr, lane, gw, NGW, it);
        }
        const int gt = vcu * 512 + tid, GT = G * 512;
        const int* posp = ARGI(pos);
        for (int i = gt; i < T * 16; i += GT) {
            const int t = i >> 4, f = i & 15;
            const float invf = powf(500000.0f, -(float)f * (1.0f / 16.0f));
            const float ang = (float)posp[t] * invf;
            double rev = (double)ang * 0.15915494309189535; rev -= rint(rev);
            float2 v; v.x = __builtin_amdgcn_cosf((float)rev); v.y = __builtin_amdgcn_sinf((float)rev);
            CS[i] = v;
        }
        for (int i = gt; i < 64 * D; i += GT) KMEAN[i] = 0.f;
        for (int i = gt; i < 2 * T; i += GT) SSQ1[i] = 0.f;
        if (bx == 0) for (int i = tid; i < XCD_BAR_WORDS; i += 512) ((unsigned*)(ws + WS_XBAR))[i] = 0u;
        norm_rows<false>(ARGF(x), ARGF(norm_mix_g), H, T, gw, NGW, lane);
        norm_rows<false>(ARGF(mem), ARGF(norm_mem_g), MEMN, NB * MEML, gw, NGW, lane);
    }
    SEAM(0);
    if (IN(1)) REPLOOP(1) { REPSYNC();
        if (rep == REPS(1) - 1 || (DUP_PART & 1)) { Gemm g{H, Win_t, T, NIN1, D}; StaticOrder S; S.init(T, NIN1, G, bx, WGM_WIDE); EpiInProj E{XR, SGR, CS, KMEAN};
          gemm_phase<EpiInProj, StaticOrder, true, true>(lds, g, S, E); }
        if (rep == REPS(1) - 1 || (DUP_PART & 2)) { Gemm g{Win_t + (size_t)NIN1 * D, H, D, T, D}; StaticOrder S; S.init(D, T, G, bx, WGM_VT); EpiStore E{VT, T, 1.f};
          gemm_phase<EpiStore, StaticOrder, true, true>(lds, g, S, E); }
    }
    SEAM(1);
#define P2_BODY(OOUT, PARTS, NOST) do { \
        if ((PARTS) & 1) conv_prepass(XR, H, ARGF(conv_w), ARGF(conv_b), vcu * 512 + tid, G * 512); \
        if (vcu < 256 && ((PARTS) & 2)) { const int bh = vcu >> 2, sub = vcu & 3, b = bh >> 4, h = bh & 15; \
            _Pragma("unroll 1") for (int ui = 0; ui < 4; ++ui) { \
                const int j = (ui == 0) ? sub : (ui == 1) ? 7 - sub : (ui == 2) ? 8 + sub : 15 - sub; \
                const size_t qoff = ((size_t)b * SEQ + 256 * j) * D + h * HD; \
                attn_unit<true>(lds, Qb + qoff, D, Kb + (size_t)b * SEQ * D + h * HD, D, VT + (size_t)(h * HD) * T + (size_t)b * SEQ, T, (OOUT) + qoff, D, 4 * (j + 1), j, KMEAN + (size_t)(b * 16) * D + h * HD, (NOST)); } } \
        if ((PARTS) & 4) { int it = 0; \
          it = tr_matrix(ARGF(w_ffn_gate), D, DFF, Wgu_t, RmGu{0}, scr, LANE_NOW(), gw, NGW, it); \
          it = tr_matrix(ARGF(w_ffn_up), D, DFF, Wgu_t, RmGu{1}, scr, LANE_NOW(), gw, NGW, it); \
          (void)it; } } while (0)
    if (IN(2)) {
#if DUP_PHASE == 2
        P2_BODY(Qb, DUP_PART, 1); XBAR();
#endif
        P2_BODY(Qb, 7, 0);
    }
    if (IN(2)) XBAR();
    if (IN(2)) {
#if DUP_PHASE == 13
        if (vcu < 256) { RnnP P{H, GY, T1, Wa_t, Wi_t, ARGF(lru_b_a), ARGF(lru_b_i), ARGF(lru_lambda)}; rnn_unit(lds, P, vcu >> 6, (vcu >> 2) & 15, vcu & 3); }
        grid.sync();
#endif
        if (vcu < 256) { RnnP P{H, GY, GY, Wa_t, Wi_t, ARGF(lru_b_a), ARGF(lru_b_i), ARGF(lru_lambda)}; rnn_unit(lds, P, vcu >> 6, (vcu >> 2) & 15, vcu & 3); }
    }
    SEAM(2);
    if (IN(3)) REPLOOP(3) { REPSYNC();
        { Gemm g{GY, Wrnn_t, T, D, D, Qb, Wattn_t, D / 64}; StaticOrder S; S.init(T, D, G, bx, WGM_NARROW); EpiGate2 E{SGR, SGA, H};
          gemm_phase<EpiGate2, StaticOrder, true, true>(lds, g, S, E); }
    }
    SEAM(3);
    if (IN(4)) REPLOOP(4) { REPSYNC(); Gemm g{H, Wmix_t, T, D, D}; StaticOrder S; S.init(T, D, G, bx, WGM_NARROW); EpiResidNorm E{ARGF(x), a.out, GY, ARGF(norm_xq_g), SSQ1};
        gemm_phase<EpiResidNorm, StaticOrder, true, true>(lds, g, S, E); }
    SEAM(4);
#ifdef EXTRA_SYNCS
    for (int es = 0; es < EXTRA_SYNCS; ++es) grid.sync();
#endif
    if (IN(6)) REPLOOP(6) { REPSYNC();
        { Gemm g{GY, Wxq_t, T, DMEM, D}; StaticOrder S; S.init(T, DMEM, G, bx); EpiStoreRS E{Q2, DMEM, QSCALE, SSQ1};
          gemm_phase<EpiStoreRS, StaticOrder, true, true>(lds, g, S, E); }
        { Gemm g{MEMN, Wxkv_t, NB * MEML, DMEM, D}; StaticOrder S; S.init(NB * MEML, DMEM, G, (bx + G - 128 % G) % G); EpiStore E{K2, DMEM, 1.f};
          gemm_phase<EpiStore, StaticOrder, true, true>(lds, g, S, E); }
        { Gemm g{Wxkv_t + (size_t)DMEM * D, MEMN, DMEM, NB * MEML, D}; StaticOrder S; S.init(DMEM, NB * MEML, G, (bx + G - 136 % G) % G); EpiStore E{V2T, NB * MEML, 1.f};
          gemm_phase<EpiStore, StaticOrder, true, true>(lds, g, S, E); }
        if (bx >= 144) (void)tr_matrix(ARGF(w_ffn_down), DFF, D, Wdown_t, RmId{}, scr, LANE_NOW(), (bx - 144) * 8 + wave, (G - 144) * 8, 0);
    }
    SEAM(6);
    if (IN(7)) REPLOOP(7) { REPSYNC();
#ifndef P7_REPS
#define P7_REPS 1
#endif
        for (int r7 = 0; r7 < P7_REPS; ++r7)
        for (int u0 = vcu; u0 < 256; u0 += G) { const int u = (u0 + 64 * r7 + 16 * r7 + r7) & 255; const int b = u >> 6, mh = (u >> 4) & 3, qb = u & 15;
            const size_t qoff = ((size_t)b * SEQ + 256 * qb) * DMEM + mh * HD;
            attn_unit<true>(lds, Q2 + qoff, DMEM, K2 + (size_t)(b * MEML) * DMEM + mh * HD, DMEM, V2T + (size_t)(mh * HD) * (NB * MEML) + b * MEML, NB * MEML, O2 + qoff, DMEM, 4, 1, nullptr); }
    }
    SEAM(7);
    if (IN(8)) { Gemm g{O2, Wxo_t, T, D, DMEM}; StaticOrder S; S.init(T, D, G, bx, WGM_NARROW); EpiResidNorm E{a.out, a.out, H, ARGF(norm_ffn_g), SSQ2};
        gemm_phase<EpiResidNorm, StaticOrder, true, true>(lds, g, S, E); }
    SEAM(8);
    if (IN(10)) REPLOOP(10) { REPSYNC(); Gemm g{H, Wgu_t, T, 2 * DFF, D}; StaticOrder S; S.init(T, 2 * DFF, G, bx, WGM_WIDE); EpiSwigluRS E{ACT, SSQ2};
        gemm_phase<EpiSwigluRS, StaticOrder, true, true>(lds, g, S, E); }
    SEAM(10);
    if (IN(11)) { Gemm g{ACT, Wdown_t, T, D, DFF}; StaticOrder S; S.init(T, D, G, bx, WGM_NARROW); EpiResid E{a.out, a.out};
        gemm_phase<EpiResid, StaticOrder, true, true>(lds, g, S, E); }
    SEAM(11);
    if (IN(12)) norm_rows<true>(a.out, ARGF(norm_final_g), a.out, T, gw, NGW, LANE_NOW());
#undef IN
#undef SEAM
}

extern "C" void kernel_launch(void* const* d_in, const int* in_sizes, int n_in, void* d_out, int out_size, void* d_ws, size_t ws_size, hipStream_t stream) {
    static int grid = 0;
    if (grid == 0) {
        if (n_in != 25 || out_size != T * D || ws_size < WS_END) { fprintf(stderr, "kernel_launch: unexpected problem (n_in %d out %d ws %zu)\n", n_in, out_size, ws_size); grid = -1; return; }
        int dev = 0, cus = 0, per_cu = 0;
        (void)hipGetDevice(&dev);
        (void)hipDeviceGetAttribute(&cus, hipDeviceAttributeMultiprocessorCount, dev);
        (void)hipFuncSetAttribute((const void*)fwd, hipFuncAttributeMaxDynamicSharedMemorySize, LDS_BYTES);
        (void)hipOccupancyMaxActiveBlocksPerMultiprocessor(&per_cu, (const void*)fwd, 512, LDS_BYTES);
        fprintf(stderr, "kernel_launch: cus %d per_cu %d ws %zu\n", cus, per_cu, ws_size);
        grid = cus > 256 ? 256 : cus;
        if (grid != 256) fprintf(stderr, "kernel_launch: expected 256 CUs, got %d\n", cus);
    }
    if (grid < 0) return;
    Args a{};
    a.x = (const float*)d_in[0]; a.mem = (const float*)d_in[1]; a.pos = (const int*)d_in[2]; a.norm_mix_g = (const float*)d_in[3]; a.w_in = (const float*)d_in[4];
    a.conv_w = (const float*)d_in[5]; a.conv_b = (const float*)d_in[6]; a.lru_w_a = (const float*)d_in[7]; a.lru_b_a = (const float*)d_in[8]; a.lru_w_i = (const float*)d_in[9];
    a.lru_b_i = (const float*)d_in[10]; a.lru_lambda = (const float*)d_in[11]; a.w_rnn_proj = (const float*)d_in[12]; a.w_attn_proj = (const float*)d_in[13]; a.w_mix_out = (const float*)d_in[14];
    a.norm_xq_g = (const float*)d_in[15]; a.norm_mem_g = (const float*)d_in[16]; a.w_xq = (const float*)d_in[17]; a.w_xkv = (const float*)d_in[18]; a.w_xo = (const float*)d_in[19];
    a.norm_ffn_g = (const float*)d_in[20]; a.w_ffn_gate = (const float*)d_in[21]; a.w_ffn_up = (const float*)d_in[22]; a.w_ffn_down = (const float*)d_in[23]; a.norm_final_g = (const float*)d_in[24];
    a.out = (float*)d_out; a.ws = (unsigned char*)d_ws;
#if MK_PER_PHASE
    for (int ph = 0; ph < NPHASE; ++ph) {
        a.ph_lo = ph; a.ph_hi = ph + 1; void* args[] = {&a};
        hipError_t e = hipLaunchCooperativeKernel((const void*)fwd, dim3(grid), dim3(512), args, LDS_BYTES, stream);
        if (e != hipSuccess) { fprintf(stderr, "launch %d failed: %s\n", ph, hipGetErrorString(e)); break; }
    }
#else
    a.ph_lo = 0; a.ph_hi = NPHASE; void* args[] = {&a};
    hipError_t e = hipLaunchCooperativeKernel((const void*)fwd, dim3(grid), dim3(512), args, LDS_BYTES, stream);
    if (e != hipSuccess) fprintf(stderr, "cooperative launch failed: %s (grid %d)\n", hipGetErrorString(e), grid);
#endif
}
```

```cpp
#include <hip/hip_runtime.h>
#include <hip/hip_cooperative_groups.h>
#include <cstdio>
#include <cstdint>
namespace cg = cooperative_groups;
namespace pg8 {
#define PG8_LAS __attribute__((address_space(3)))
typedef unsigned short bf16_t;
typedef short bf16x8 __attribute__((ext_vector_type(8)));
typedef float f32x4 __attribute__((ext_vector_type(4)));
typedef unsigned u32x4 __attribute__((ext_vector_type(4)));
constexpr int BM = 256, BK = 64, HALF = 128, HTB = HALF * BK * 2  , STAGE_BYTES = 8 * HTB, NXCD = 8, WGM = 4;

__host__ __device__ __forceinline__ int lds_byte(int r, int c) { const int st = (r >> 4) * 2 + (c >> 5), rr = r & 15, cc = c & 31, ob = rr * 64 + cc * 2; return st * 1024 + (ob ^ (((ob >> 9) & 1) << 5)); }
__host__ __device__ __forceinline__ void stage_rc(int b, int& R, int& C) { const int st = b / 1024, sb = b % 1024, swz = sb ^ (((sb >> 9) & 1) << 5); R = (st >> 1) * 16 + swz / 64; C = (st & 1) * 32 + (swz % 64) / 2; }
__host__ __device__ __forceinline__ int perm32(int rho) { const int n = rho >> 4, i = rho & 15; return 8 * (i >> 2) + 4 * n + (i & 3); }

struct Unit { int pm, pn; };
struct Gemm { const bf16_t* A; const bf16_t* Bt; int M, N, K; const bf16_t* A2 = nullptr; const bf16_t* Bt2 = nullptr; int nt2 = 0; };

struct StaticOrder {
    int nM, nN, nwg, G, c, wgm;
    __host__ __device__ void init(int M, int N, int G_, int c_, int wgm_ = WGM) { nM = M / BM; nN = N / BM; nwg = nM * nN; G = G_; c = c_; wgm = wgm_; }
    __host__ __device__ bool next(int i, Unit& u) const {
        const long L = (long)i * G + c; if (L >= nwg) return false;
        int wgid = (int)L; { const int q = nwg / NXCD, r = nwg % NXCD, xcd = wgid % NXCD, off = wgid / NXCD; wgid = (xcd < r ? xcd * (q + 1) : r * (q + 1) + (xcd - r) * q) + off; }
        const int nig = wgm * nN, gid = wgid / nig, fm = gid * wgm, gsz = (nM - fm) < wgm ? (nM - fm) : wgm;
        u.pm = fm + ((wgid % nig) % gsz); u.pn = (wgid % nig) / gsz; return true;
    }
    __device__ __forceinline__ void a_ready(const Unit&) const {}
    __device__ __forceinline__ void done(const Unit&) const {}
};

__device__ __forceinline__ unsigned cvt_pk_bf16(float lo, float hi) { unsigned r; asm volatile("v_cvt_pk_bf16_f32 %0, %1, %2" : "=v"(r) : "v"(lo), "v"(hi)); return r; }
typedef float f32x2 __attribute__((ext_vector_type(2)));
template <class E, class = void> struct HasMid { static constexpr bool value = false; };
template <class E> struct HasMid<E, decltype((void)E::HAS_MID)> { static constexpr bool value = true; };
template <class Epi, class Sched, bool ALIGN_EPI = false, bool SP2 = false>
__device__ __forceinline__ void gemm_phase(PG8_LAS unsigned char* lds, const Gemm g, const Sched& S, const Epi& E) {
    int tid_l = threadIdx.x; asm volatile("" : "+v"(tid_l));
    const int tid = tid_l, wid = __builtin_amdgcn_readfirstlane(tid >> 6), lane = tid & 63, wr = wid >> 2, wc = wid & 3, fr = lane & 15, fq = lane >> 4;
    const int K = g.K, ns = K / BK, nt = ns + g.nt2;
    unsigned voffA[2], voffB[2];
#pragma unroll
    for (int i = 0; i < 2; ++i) { int R, C; stage_rc(tid * 16 + i * 8192, R, C); const int Rb = Epi::PERM ? ((R & ~31) + perm32(R & 31)) : R;
        voffA[i] = (unsigned)(R * K + C) * 2u; voffB[i] = (unsigned)(Rb * K + C) * 2u; }
    const size_t kstep = (size_t)(BK * 2);
    const size_t hstep = (size_t)HALF * K * 2;
    const size_t tstep = 2 * hstep;
    const unsigned ldsw = (unsigned)wid * 1024u;
    const int aoff = lds_byte(wr * 64 + fr, fq * 8), boff = lds_byte(wc * 32 + fr, fq * 8);
#define PG8_SA(b, h) (((b) * 2 + (h)) * HTB)
#define PG8_SB(b, h) ((4 + (b) * 2 + (h)) * HTB)
#ifndef PG8_AUX_A
#define PG8_AUX_A 0
#endif
#ifndef PG8_AUX_B
#define PG8_AUX_B 0
#endif
#define PG8_STAGE_X(bufoff, gbase, voff, AUX) do { _Pragma("unroll") for (int _i = 0; _i < 2; ++_i) \
        __builtin_amdgcn_global_load_lds((const unsigned*)((const char*)(gbase) + (voff)[_i]), (PG8_LAS unsigned*)(lds + (bufoff) + ldsw + _i * 8192), 16, 0, AUX); } while (0)
#define PG8_STAGEA(bufoff, gbase, voff) PG8_STAGE_X(bufoff, gbase, voff, PG8_AUX_A)
#define PG8_STAGEB(bufoff, gbase, voff) PG8_STAGE_X(bufoff, gbase, voff, PG8_AUX_B)
#define PG8_LDA(dst, b, h) do { _Pragma("unroll") for (int m = 0; m < 4; ++m) _Pragma("unroll") for (int k = 0; k < 2; ++k) dst[m][k] = *(const PG8_LAS bf16x8*)(lds + PG8_SA(b, h) + aoff + m * 2048 + k * 1024); } while (0)
#define PG8_LDB(dst, b, h) do { _Pragma("unroll") for (int n = 0; n < 2; ++n) _Pragma("unroll") for (int k = 0; k < 2; ++k) dst[n][k] = *(const PG8_LAS bf16x8*)(lds + PG8_SB(b, h) + boff + n * 2048 + k * 1024); } while (0)
#define PG8_MMA(ai, bj, At, Bt) do { __builtin_amdgcn_s_setprio(1); _Pragma("unroll") for (int m = 0; m < 4; ++m) _Pragma("unroll") for (int n = 0; n < 2; ++n) _Pragma("unroll") for (int k = 0; k < 2; ++k) \
        acc[ai][bj][m][n] = __builtin_amdgcn_mfma_f32_16x16x32_bf16(Bt[n][k], At[m][k], acc[ai][bj][m][n], 0, 0, 0); __builtin_amdgcn_s_setprio(0); } while (0)
#define PG8_WAIT_V(n) asm volatile("s_waitcnt vmcnt(" #n ")" ::: "memory")
#define PG8_WAIT_L(n) asm volatile("s_waitcnt lgkmcnt(" #n ")" ::: "memory")
#define PG8_BAR __builtin_amdgcn_s_barrier()
#define PG8_SCHED __builtin_amdgcn_sched_barrier(0)
    Unit cur, nxt; int ui = 0;
    if (!S.next(0, cur)) return;
    f32x4 acc[2][2][4][2];
#pragma unroll
    for (int a = 0; a < 2; ++a)
#pragma unroll
        for (int b = 0; b < 2; ++b)
#pragma unroll
            for (int m = 0; m < 4; ++m)
#pragma unroll
                for (int n = 0; n < 2; ++n) acc[a][b][m][n] = (f32x4){0.f, 0.f, 0.f, 0.f};
    bf16x8 At[4][2], B0[2][2], B1[2][2];
    const char* cA = (const char*)g.A + (size_t)cur.pm * tstep; const char* cB = (const char*)g.Bt + (size_t)cur.pn * tstep;
    const char* cA2 = g.nt2 ? (const char*)g.A2 + (size_t)cur.pm * tstep - (size_t)ns * (BK * 2) : cA; const char* cB2 = g.nt2 ? (const char*)g.Bt2 + (size_t)cur.pn * tstep - (size_t)ns * (BK * 2) : cB;
    S.a_ready(cur);
    if constexpr (SP2) {
        PG8_STAGEB(PG8_SB(0, 0), cB, voffB); PG8_STAGEB(PG8_SB(0, 1), cB + hstep, voffB); PG8_STAGEA(PG8_SA(0, 0), cA, voffA); PG8_STAGEA(PG8_SA(0, 1), cA + hstep, voffA);
        if (wr == 1) PG8_BAR;
        PG8_WAIT_V(2); PG8_BAR;
        PG8_STAGEB(PG8_SB(1, 0), cB + kstep, voffB); PG8_STAGEA(PG8_SA(1, 0), cA + kstep, voffA); PG8_STAGEB(PG8_SB(1, 1), cB + hstep + kstep, voffB);
        PG8_WAIT_V(6); PG8_BAR;
    } else {
        PG8_STAGEB(PG8_SB(0, 0), cB, voffB); PG8_STAGEA(PG8_SA(0, 0), cA, voffA); PG8_STAGEB(PG8_SB(0, 1), cB + hstep, voffB); PG8_STAGEA(PG8_SA(0, 1), cA + hstep, voffA);
        if (wr == 1) PG8_BAR;
        PG8_WAIT_V(4); PG8_BAR;
        PG8_STAGEB(PG8_SB(1, 0), cB + kstep, voffB); PG8_STAGEA(PG8_SA(1, 0), cA + kstep, voffA); PG8_STAGEB(PG8_SB(1, 1), cB + hstep + kstep, voffB);
        PG8_WAIT_V(6); PG8_BAR;
    }
    for (;;) {
        const bool has_next = S.next(ui + 1, nxt);
        const char* nA = has_next ? (const char*)g.A + (size_t)nxt.pm * tstep : cA; const char* nB = has_next ? (const char*)g.Bt + (size_t)nxt.pn * tstep : cB;
        const char* nA2 = (has_next && g.nt2) ? (const char*)g.A2 + (size_t)nxt.pm * tstep - (size_t)ns * (BK * 2) : cA2; const char* nB2 = (has_next && g.nt2) ? (const char*)g.Bt2 + (size_t)nxt.pn * tstep - (size_t)ns * (BK * 2) : cB2;
        for (int t = 0; t < nt; t += 2) {
            const bool last = (t == nt - 2);
            if constexpr (HasMid<Epi>::value) { if (t == ns) E.mid(acc, cur, wr, wc, fr, fq); }
            const char* sA1 = (t + 1 >= ns) ? cA2 : cA; const char* sA2 = (t + 2 >= ns) ? cA2 : cA; const char* sB2 = (t + 2 >= ns) ? cB2 : cB;
            const char* a1 = sA1 + (size_t)(t + 1) * kstep;
            const char* a2 = last ? nA : sA2 + (size_t)(t + 2) * kstep; const char* b2 = last ? nB : sB2 + (size_t)(t + 2) * kstep;
            const char* a3 = a2 + kstep; const char* b3 = b2 + kstep;
            if (last && has_next) S.a_ready(nxt);
            if constexpr (SP2) {
            PG8_LDB(B0, 0, 0); PG8_LDB(B1, 0, 1); PG8_SCHED; PG8_LDA(At, 0, 0); PG8_STAGEA(PG8_SA(1, 1), a1 + hstep, voffA);
            PG8_WAIT_V(8); PG8_WAIT_L(0); PG8_BAR; PG8_MMA(0, 0, At, B0); PG8_MMA(0, 1, At, B1); PG8_BAR; PG8_SCHED;
            PG8_LDA(At, 0, 1); PG8_STAGEB(PG8_SB(0, 0), b2, voffB); PG8_STAGEB(PG8_SB(0, 1), b2 + hstep, voffB); PG8_STAGEA(PG8_SA(0, 0), a2, voffA);
            PG8_WAIT_V(8); PG8_WAIT_L(0); PG8_BAR; PG8_MMA(1, 0, At, B0); PG8_MMA(1, 1, At, B1); PG8_BAR; PG8_SCHED;
            PG8_LDB(B0, 1, 0); PG8_LDB(B1, 1, 1); PG8_SCHED; PG8_LDA(At, 1, 0); PG8_STAGEA(PG8_SA(0, 1), a2 + hstep, voffA);
            PG8_WAIT_V(8); PG8_WAIT_L(0); PG8_BAR; PG8_MMA(0, 0, At, B0); PG8_MMA(0, 1, At, B1); PG8_BAR; PG8_SCHED;
            PG8_LDA(At, 1, 1); PG8_STAGEB(PG8_SB(1, 0), b3, voffB); PG8_STAGEB(PG8_SB(1, 1), b3 + hstep, voffB); PG8_STAGEA(PG8_SA(1, 0), a3, voffA);
            PG8_WAIT_V(8); PG8_WAIT_L(0); PG8_BAR; PG8_MMA(1, 0, At, B0); PG8_MMA(1, 1, At, B1); PG8_BAR; PG8_SCHED;
            } else {
            PG8_LDB(B0, 0, 0); PG8_SCHED; PG8_LDA(At, 0, 0); PG8_STAGEA(PG8_SA(1, 1), a1 + hstep, voffA);
            PG8_WAIT_L(8); PG8_BAR; PG8_WAIT_L(0); PG8_MMA(0, 0, At, B0); PG8_BAR; PG8_SCHED;
            PG8_LDB(B1, 0, 1); PG8_STAGEB(PG8_SB(0, 0), b2, voffB);
            PG8_BAR; PG8_WAIT_L(0); PG8_MMA(0, 1, At, B1); PG8_BAR;
            PG8_LDA(At, 0, 1); PG8_STAGEA(PG8_SA(0, 0), a2, voffA);
            PG8_BAR; PG8_WAIT_L(0); PG8_MMA(1, 0, At, B0); PG8_BAR; PG8_SCHED;
            PG8_STAGEB(PG8_SB(0, 1), b2 + hstep, voffB);
            PG8_WAIT_V(6); PG8_BAR; PG8_MMA(1, 1, At, B1); PG8_BAR;
            PG8_LDB(B0, 1, 0); PG8_SCHED; PG8_LDA(At, 1, 0); PG8_STAGEA(PG8_SA(0, 1), a2 + hstep, voffA);
            PG8_WAIT_L(8); PG8_BAR; PG8_WAIT_L(0); PG8_MMA(0, 0, At, B0); PG8_BAR; PG8_SCHED;
            PG8_LDB(B1, 1, 1); PG8_STAGEB(PG8_SB(1, 0), b3, voffB);
            PG8_BAR; PG8_WAIT_L(0); PG8_MMA(0, 1, At, B1); PG8_BAR;
            PG8_LDA(At, 1, 1); PG8_STAGEA(PG8_SA(1, 0), a3, voffA);
            PG8_BAR; PG8_WAIT_L(0); PG8_MMA(1, 0, At, B0); PG8_BAR; PG8_SCHED;
            PG8_STAGEB(PG8_SB(1, 1), b3 + hstep, voffB);
            PG8_WAIT_V(6); PG8_BAR; PG8_MMA(1, 1, At, B1); PG8_BAR;
            }
        }
        if constexpr (ALIGN_EPI) { if (wr == 0) PG8_BAR; }
        if constexpr (!Epi::AFTER_DRAIN) { E(acc, cur, wr, wc, fr, fq); S.done(cur); }
        if (!has_next) break;
#pragma unroll
        for (int a = 0; a < 2; ++a)
#pragma unroll
            for (int b = 0; b < 2; ++b)
#pragma unroll
                for (int m = 0; m < 4; ++m)
#pragma unroll
                    for (int n = 0; n < 2; ++n) acc[a][b][m][n] = (f32x4){0.f, 0.f, 0.f, 0.f};
        cur = nxt; cA = nA; cB = nB; cA2 = nA2; cB2 = nB2; ++ui;
        if constexpr (ALIGN_EPI) { if (wr == 1) PG8_BAR; }
    }
    PG8_WAIT_V(0);
    if constexpr (!ALIGN_EPI) { if (wr == 0) PG8_BAR; }
    PG8_BAR;
    if constexpr (Epi::AFTER_DRAIN) { E.fused(acc, cur, wr, wc, fr, fq, lds, wid, lane); S.done(cur); }
#undef PG8_SA
#undef PG8_SB
#undef PG8_STAGE_X
#undef PG8_STAGEA
#undef PG8_STAGEB
#undef PG8_LDA
#undef PG8_LDB
#undef PG8_MMA
#undef PG8_WAIT_V
#undef PG8_WAIT_L
#undef PG8_BAR
#undef PG8_SCHED
}
}

using namespace pg8;
#define LAS __attribute__((address_space(3)))
typedef float f32x16 __attribute__((ext_vector_type(16)));
typedef unsigned u32x2 __attribute__((ext_vector_type(2)));

constexpr int NB = 4, SEQ = 4096, T = NB * SEQ, D = 2048, NH = 16, HD = 128, DFF = 5632, MEML = 256, DMEM = 512;
constexpr int NIN1 = 12288;
constexpr float RMS_EPS = 1e-6f;
constexpr float QSCALE = 0.08838834764831845f * 1.4426950408889634f;
constexpr float NEGBIG = -1e30f;

constexpr size_t MiB = 1u << 20;
constexpr size_t WS_WIN = 1 * MiB;
constexpr size_t WS_WGU = WS_WIN;
constexpr size_t WS_WGATE = 57 * MiB;
constexpr size_t WS_WRNN = 58 * MiB, WS_WATTN = 66 * MiB, WS_WMIX = 74 * MiB;
constexpr size_t WS_WXQ = 82 * MiB;
constexpr size_t WS_WXKV = 84 * MiB;
constexpr size_t WS_WXO = 88 * MiB;
constexpr size_t WS_K2 = 90 * MiB;
constexpr size_t WS_V2T = 91 * MiB;
constexpr size_t WS_KMEAN = 92 * MiB;
constexpr size_t WS_CS = 93 * MiB;
constexpr size_t WS_MEMN = 95 * MiB;
constexpr size_t WS_H = 104 * MiB;
constexpr size_t WS_XR = 168 * MiB;
constexpr size_t WS_GY = 232 * MiB, WS_Q = 296 * MiB, WS_K = 360 * MiB;
constexpr size_t WS_VT = 424 * MiB;
constexpr size_t WS_WDOWN = 488 * MiB;
constexpr size_t WS_ACT = 168 * MiB;
constexpr size_t WS_Q2 = 360 * MiB, WS_O2 = 376 * MiB;
constexpr size_t WS_T1 = WS_XR;
constexpr size_t WS_END = 512 * MiB;
constexpr size_t SEG_ELEMS = (size_t)T * D;

constexpr int LDS_BYTES = 147456;
constexpr int LDS_XB_ST = 147392;
constexpr size_t WS_XBAR = 512 * 1024;

__device__ __forceinline__ unsigned f2bf(float f) { unsigned u = __builtin_bit_cast(unsigned, f); return (u + 0x7fffu + ((u >> 16) & 1u)) >> 16; }
__device__ __forceinline__ unsigned pk2(float lo, float hi) { return cvt_pk_bf16(lo, hi); }
__device__ __forceinline__ float bflo(unsigned w) { return __builtin_bit_cast(float, w << 16); }
__device__ __forceinline__ float bfhi(unsigned w) { return __builtin_bit_cast(float, w & 0xffff0000u); }
__device__ __forceinline__ float sigm(float x) { return __builtin_amdgcn_rcpf(1.f + __builtin_amdgcn_exp2f(-1.4426950408889634f * x)); }
__device__ __forceinline__ float gelu_tanh(float x) { return x * sigm(1.5957691216057308f * (x + 0.044715f * x * x * x)); }
__device__ __forceinline__ float wave_sum(float v) {
#pragma unroll
    for (int o = 1; o < 64; o <<= 1) v += __shfl_xor(v, o);
    return v;
}

__device__ __forceinline__ void st8(bf16_t* p, const f32x4& a, const f32x4& b) { u32x4 w; w.x = pk2(a[0], a[1]); w.y = pk2(a[2], a[3]); w.z = pk2(b[0], b[1]); w.w = pk2(b[2], b[3]); *(u32x4*)p = w; }

struct EpiInProj {
    static constexpr bool PERM = true, AFTER_DRAIN = false;
    bf16_t* act0; bf16_t* gate0; const float2* cs; float* kmean;
    __device__ __forceinline__ void operator()(const f32x4 (&acc)[2][2][4][2], const Unit& u, int wr, int wc, int fr, int fq) const {
        const int seg = u.pn >> 3, colt = (u.pn & 7) * 256;
        bf16_t* base = seg < 4 ? act0 + (size_t)seg * SEG_ELEMS : gate0 + (size_t)(seg - 4) * SEG_ELEMS;
        const int row0 = u.pm * 256 + wr * 64 + fr, col0 = colt + wc * 32 + 8 * fq;
        if (seg == 2 || seg == 3) {
            const bool roped = (wc == 0);
            const float sc = (seg == 2) ? QSCALE : 1.f;
            const float sgn = (fq < 2) ? -1.f : 1.f;
            f32x4 ks[2][2];
#pragma unroll
            for (int bj = 0; bj < 2; ++bj) { ks[bj][0] = (f32x4){0.f, 0.f, 0.f, 0.f}; ks[bj][1] = (f32x4){0.f, 0.f, 0.f, 0.f}; }
#pragma unroll
            for (int ai = 0; ai < 2; ++ai)
#pragma unroll
                for (int m = 0; m < 4; ++m) {
                    const int row = row0 + ai * 128 + m * 16;
                    f32x4 c0, s0, c1, s1;
                    if (roped) { const f32x4* cp = (const f32x4*)(cs + (size_t)row * 16 + 8 * (fq & 1));
                        const f32x4 t0 = cp[0], t1 = cp[1], t2 = cp[2], t3 = cp[3];
                        c0 = (f32x4){t0[0], t0[2], t1[0], t1[2]}; s0 = (f32x4){t0[1], t0[3], t1[1], t1[3]};
                        c1 = (f32x4){t2[0], t2[2], t3[0], t3[2]}; s1 = (f32x4){t2[1], t2[3], t3[1], t3[3]}; }
#pragma unroll
                    for (int bj = 0; bj < 2; ++bj) {
                        f32x4 v0 = acc[ai][bj][m][0], v1 = acc[ai][bj][m][1];
                        if (roped) {
                            f32x4 p0, p1;
#pragma unroll
                            for (int e = 0; e < 4; ++e) { p0[e] = __shfl_xor(v0[e], 32); p1[e] = __shfl_xor(v1[e], 32); }
                            v0 = v0 * c0 + (p0 * s0) * sgn; v1 = v1 * c1 + (p1 * s1) * sgn;
                        }
                        if (seg == 3) { ks[bj][0] += v0; ks[bj][1] += v1; }
                        st8(base + (size_t)row * D + col0 + bj * 128, v0 * sc, v1 * sc);
                    }
                }
            if (seg == 3) {
#pragma unroll
                for (int bj = 0; bj < 2; ++bj)
#pragma unroll
                    for (int n = 0; n < 2; ++n)
#pragma unroll
                        for (int e = 0; e < 4; ++e) { float s = ks[bj][n][e]; s += __shfl_xor(s, 1); s += __shfl_xor(s, 2); s += __shfl_xor(s, 4); s += __shfl_xor(s, 8);
                            if (fr == 0) atomicAdd(kmean + (size_t)u.pm * D + col0 + bj * 128 + 4 * n + e, s); }
            }
        } else {
#pragma unroll
            for (int ai = 0; ai < 2; ++ai)
#pragma unroll
                for (int m = 0; m < 4; ++m) {
                    const int row = row0 + ai * 128 + m * 16;
#pragma unroll
                    for (int bj = 0; bj < 2; ++bj) {
                        f32x4 v0 = acc[ai][bj][m][0], v1 = acc[ai][bj][m][1];
                        if (seg == 1) {
#pragma unroll
                            for (int e = 0; e < 4; ++e) { v0[e] = gelu_tanh(v0[e]); v1[e] = gelu_tanh(v1[e]); }
                        } else if (seg >= 4) {
#pragma unroll
                            for (int e = 0; e < 4; ++e) { v0[e] = sigm(v0[e]); v1[e] = sigm(v1[e]); }
                        }
                        st8(base + (size_t)row * D + col0 + bj * 128, v0, v1);
                    }
                }
        }
    }
};

struct EpiStore {
    static constexpr bool PERM = true, AFTER_DRAIN = false;
    bf16_t* O; int ldc; float sc;
    __device__ __forceinline__ void operator()(const f32x4 (&acc)[2][2][4][2], const Unit& u, int wr, int wc, int fr, int fq) const {
        const int row0 = u.pm * 256 + wr * 64 + fr, col0 = u.pn * 256 + wc * 32 + 8 * fq;
#pragma unroll
        for (int ai = 0; ai < 2; ++ai)
#pragma unroll
            for (int m = 0; m < 4; ++m) {
                bf16_t* rp = O + (size_t)(row0 + ai * 128 + m * 16) * ldc + col0;
#pragma unroll
                for (int bj = 0; bj < 2; ++bj) st8(rp + bj * 128, acc[ai][bj][m][0] * sc, acc[ai][bj][m][1] * sc);
            }
    }
};

struct EpiGate {
    static constexpr bool PERM = true, AFTER_DRAIN = false;
    const bf16_t* G; const bf16_t* P; bf16_t* O; int MODE;
    __device__ __forceinline__ void operator()(const f32x4 (&acc)[2][2][4][2], const Unit& u, int wr, int wc, int fr, int fq) const {
        const int row0 = u.pm * 256 + wr * 64 + fr, col0 = u.pn * 256 + wc * 32 + 8 * fq;
#pragma unroll
        for (int ai = 0; ai < 2; ++ai)
#pragma unroll
            for (int m = 0; m < 4; ++m) {
                const size_t off = (size_t)(row0 + ai * 128 + m * 16) * D + col0;
#pragma unroll
                for (int bj = 0; bj < 2; ++bj) {
                    const u32x4 g = *(const u32x4*)(G + off + bj * 128);
                    f32x4 v0 = acc[ai][bj][m][0], v1 = acc[ai][bj][m][1];
                    v0 = v0 * (f32x4){bflo(g.x), bfhi(g.x), bflo(g.y), bfhi(g.y)}; v1 = v1 * (f32x4){bflo(g.z), bfhi(g.z), bflo(g.w), bfhi(g.w)};
                    if (MODE == 1) { const u32x4 p = *(const u32x4*)(P + off + bj * 128);
                        v0 = v0 + (f32x4){bflo(p.x), bfhi(p.x), bflo(p.y), bfhi(p.y)}; v1 = v1 + (f32x4){bflo(p.z), bfhi(p.z), bflo(p.w), bfhi(p.w)}; }
                    st8(O + off + bj * 128, v0, v1);
                }
            }
    }
};

struct EpiGate2 {
    static constexpr bool PERM = true, AFTER_DRAIN = false, HAS_MID = true;
    const bf16_t* GR; const bf16_t* GA; bf16_t* O;
    __device__ __forceinline__ void mid(f32x4 (&acc)[2][2][4][2], const Unit& u, int wr, int wc, int fr, int fq) const {
        int row0 = u.pm * 256 + wr * 64 + fr; const int col0 = u.pn * 256 + wc * 32 + 8 * fq;
        asm volatile("" : "+v"(row0));
#pragma unroll
        for (int ai = 0; ai < 2; ++ai)
#pragma unroll
            for (int m = 0; m < 4; ++m) {
                asm volatile("" ::: "memory");
                const size_t off = (size_t)(row0 + ai * 128 + m * 16) * D + col0;
#pragma unroll
                for (int bj = 0; bj < 2; ++bj) {
                    const u32x4 r = *(const u32x4*)(GR + off + bj * 128), g = *(const u32x4*)(GA + off + bj * 128);
                    const f32x4 r0 = (f32x4){bflo(r.x), bfhi(r.x), bflo(r.y), bfhi(r.y)}, r1 = (f32x4){bflo(r.z), bfhi(r.z), bflo(r.w), bfhi(r.w)};
                    f32x4 q0, q1;
                    q0[0] = __builtin_amdgcn_rcpf(fmaxf(bflo(g.x), 1e-30f)); q0[1] = __builtin_amdgcn_rcpf(fmaxf(bfhi(g.x), 1e-30f)); q0[2] = __builtin_amdgcn_rcpf(fmaxf(bflo(g.y), 1e-30f)); q0[3] = __builtin_amdgcn_rcpf(fmaxf(bfhi(g.y), 1e-30f));
                    q1[0] = __builtin_amdgcn_rcpf(fmaxf(bflo(g.z), 1e-30f)); q1[1] = __builtin_amdgcn_rcpf(fmaxf(bfhi(g.z), 1e-30f)); q1[2] = __builtin_amdgcn_rcpf(fmaxf(bflo(g.w), 1e-30f)); q1[3] = __builtin_amdgcn_rcpf(fmaxf(bfhi(g.w), 1e-30f));
                    acc[ai][bj][m][0] = acc[ai][bj][m][0] * (r0 * q0); acc[ai][bj][m][1] = acc[ai][bj][m][1] * (r1 * q1);
                }
            }
    }
    __device__ __forceinline__ void operator()(const f32x4 (&acc)[2][2][4][2], const Unit& u, int wr, int wc, int fr, int fq) const {
        const int row0 = u.pm * 256 + wr * 64 + fr, col0 = u.pn * 256 + wc * 32 + 8 * fq;
#pragma unroll
        for (int ai = 0; ai < 2; ++ai)
#pragma unroll
            for (int m = 0; m < 4; ++m) {
                const size_t off = (size_t)(row0 + ai * 128 + m * 16) * D + col0;
#pragma unroll
                for (int bj = 0; bj < 2; ++bj) {
                    const u32x4 g = *(const u32x4*)(GA + off + bj * 128);
                    st8(O + off + bj * 128, acc[ai][bj][m][0] * (f32x4){bflo(g.x), bfhi(g.x), bflo(g.y), bfhi(g.y)}, acc[ai][bj][m][1] * (f32x4){bflo(g.z), bfhi(g.z), bflo(g.w), bfhi(g.w)});
                }
            }
    }
};

struct EpiSwiglu {
    static constexpr bool PERM = true, AFTER_DRAIN = false;
    bf16_t* O;
    __device__ __forceinline__ void operator()(const f32x4 (&acc)[2][2][4][2], const Unit& u, int wr, int wc, int fr, int fq) const {
        const int row0 = u.pm * 256 + wr * 64 + fr, col0 = u.pn * 128 + wc * 32 + 8 * fq;
#pragma unroll
        for (int ai = 0; ai < 2; ++ai)
#pragma unroll
            for (int m = 0; m < 4; ++m) {
                f32x4 v0, v1;
#pragma unroll
                for (int e = 0; e < 4; ++e) { const float g0 = acc[ai][0][m][0][e], g1 = acc[ai][0][m][1][e];
                    v0[e] = g0 * sigm(g0) * acc[ai][1][m][0][e]; v1[e] = g1 * sigm(g1) * acc[ai][1][m][1][e]; }
                st8(O + (size_t)(row0 + ai * 128 + m * 16) * DFF + col0, v0, v1);
            }
    }
};

struct EpiResid {
    static constexpr bool PERM = false, AFTER_DRAIN = false;
    const float* base; float* out;
    __device__ __forceinline__ void operator()(const f32x4 (&acc)[2][2][4][2], const Unit& u, int wr, int wc, int fr, int fq) const {
        const int row0 = u.pm * 256 + wr * 64 + fr, col0 = u.pn * 256 + wc * 32 + 4 * fq;
#pragma unroll
        for (int ai = 0; ai < 2; ++ai)
#pragma unroll
            for (int m = 0; m < 4; ++m) {
                const size_t off = (size_t)(row0 + ai * 128 + m * 16) * D + col0;
#pragma unroll
                for (int bj = 0; bj < 2; ++bj)
#pragma unroll
                    for (int n = 0; n < 2; ++n) { const f32x4 b = *(const f32x4*)(base + off + bj * 128 + n * 16); *(f32x4*)(out + off + bj * 128 + n * 16) = b + acc[ai][bj][m][n]; }
            }
    }
};

struct EpiResidNorm {
    static constexpr bool PERM = false, AFTER_DRAIN = false;
    const float* base; float* out; bf16_t* xg; const float* gain; float* ssq;
    __device__ __forceinline__ void operator()(const f32x4 (&acc)[2][2][4][2], const Unit& u, int wr, int wc, int fr, int fq) const {
        const int row0 = u.pm * 256 + wr * 64 + fr, col0 = u.pn * 256 + wc * 32 + 4 * fq;
        f32x4 gv[2][2];
#pragma unroll
        for (int bj = 0; bj < 2; ++bj)
#pragma unroll
            for (int n = 0; n < 2; ++n) gv[bj][n] = *(const f32x4*)(gain + col0 + bj * 128 + n * 16);
#pragma unroll
        for (int ai = 0; ai < 2; ++ai)
#pragma unroll
            for (int m = 0; m < 4; ++m) {
                const int row = row0 + ai * 128 + m * 16; const size_t off = (size_t)row * D + col0;
                float s = 0.f;
#pragma unroll
                for (int bj = 0; bj < 2; ++bj)
#pragma unroll
                    for (int n = 0; n < 2; ++n) { const f32x4 b = *(const f32x4*)(base + off + bj * 128 + n * 16); const f32x4 o = b + acc[ai][bj][m][n];
                        *(f32x4*)(out + off + bj * 128 + n * 16) = o; s += (o[0] * o[0] + o[1] * o[1]) + (o[2] * o[2] + o[3] * o[3]);
                        const f32x4 y = o * gv[bj][n]; u32x2 w; w.x = pk2(y[0], y[1]); w.y = pk2(y[2], y[3]); *(u32x2*)(xg + off + bj * 128 + n * 16) = w; }
                s += __shfl_xor(s, 16); s += __shfl_xor(s, 32);
                if (fq == 0) atomicAdd(ssq + row, s);
            }
    }
};
struct EpiStoreRS {
    static constexpr bool PERM = true, AFTER_DRAIN = false;
    bf16_t* O; int ldc; float sc; const float* ssq;
    __device__ __forceinline__ void operator()(const f32x4 (&acc)[2][2][4][2], const Unit& u, int wr, int wc, int fr, int fq) const {
        const int row0 = u.pm * 256 + wr * 64 + fr, col0 = u.pn * 256 + wc * 32 + 8 * fq;
#pragma unroll
        for (int ai = 0; ai < 2; ++ai)
#pragma unroll
            for (int m = 0; m < 4; ++m) {
                const int row = row0 + ai * 128 + m * 16; const float rs = sc * (1.0f / sqrtf(ssq[row] * (1.f / D) + RMS_EPS));
                bf16_t* rp = O + (size_t)row * ldc + col0;
#pragma unroll
                for (int bj = 0; bj < 2; ++bj) st8(rp + bj * 128, acc[ai][bj][m][0] * rs, acc[ai][bj][m][1] * rs);
            }
    }
};
struct EpiSwigluRS {
    static constexpr bool PERM = true, AFTER_DRAIN = false;
    bf16_t* O; const float* ssq;
    __device__ __forceinline__ void operator()(const f32x4 (&acc)[2][2][4][2], const Unit& u, int wr, int wc, int fr, int fq) const {
        const int row0 = u.pm * 256 + wr * 64 + fr, col0 = u.pn * 128 + wc * 32 + 8 * fq;
#pragma unroll
        for (int ai = 0; ai < 2; ++ai)
#pragma unroll
            for (int m = 0; m < 4; ++m) {
                const int row = row0 + ai * 128 + m * 16; const float rs = 1.0f / sqrtf(ssq[row] * (1.f / D) + RMS_EPS);
                f32x4 v0, v1;
#pragma unroll
                for (int e = 0; e < 4; ++e) { const float g0 = acc[ai][0][m][0][e] * rs, g1 = acc[ai][0][m][1][e] * rs;
                    v0[e] = g0 * sigm(g0) * (acc[ai][1][m][0][e] * rs); v1[e] = g1 * sigm(g1) * (acc[ai][1][m][1][e] * rs); }
                st8(O + (size_t)row * DFF + col0, v0, v1);
            }
    }
};

__device__ __forceinline__ void tr_item(const float* W, int K, int N, bf16_t* WT, int row_off, int k0, int n0, LAS unsigned char* scr, int lane) {
    const int ng = lane & 15, kg = lane >> 4;
    const float* src = W + (size_t)(k0 + 4 * kg) * N + n0 + 4 * ng;
    f32x4 v[4][4];
#pragma unroll
    for (int s = 0; s < 4; ++s)
#pragma unroll
        for (int j = 0; j < 4; ++j) v[s][j] = *(const f32x4*)(src + (size_t)(16 * s + j) * N);
#pragma unroll
    for (int s = 0; s < 4; ++s)
#pragma unroll
        for (int e = 0; e < 4; ++e) { u32x2 o; o.x = pk2(v[s][0][e], v[s][1][e]); o.y = pk2(v[s][2][e], v[s][3][e]);
            *(LAS u32x2*)(scr + (4 * ng + e) * 128 + (((2 * s + (kg >> 1)) ^ (ng & 7)) << 4) + (kg & 1) * 8) = o; }
    asm volatile("s_waitcnt lgkmcnt(0)" ::: "memory");
#pragma unroll
    for (int i = 0; i < 8; ++i) { const int n = 8 * i + (lane >> 3), c = lane & 7;
        const u32x4 o = *(const LAS u32x4*)(scr + n * 128 + ((c ^ ((n >> 2) & 7)) << 4));
        *(u32x4*)(WT + (size_t)(row_off + n0 + n) * K + k0 + 8 * c) = o; }
    asm volatile("s_waitcnt lgkmcnt(0)" ::: "memory");
}
template <class RowMap>
__device__ __forceinline__ int tr_matrix(const float* W, int K, int N, bf16_t* WT, RowMap rm, LAS float* scr, int lane_, int gw, int NGW, int it0) {
    int lane = lane_; asm volatile("" : "+v"(lane));
    const int nblk = N / 64, nitems = (K / 64) * nblk;
    int first = ((gw - it0) % NGW + NGW) % NGW;
    for (int it = first; it < nitems; it += NGW) { const int kb = it / nblk, nb = it % nblk; tr_item(W, K, N, WT, rm(nb * 64), kb * 64, nb * 64, (LAS unsigned char*)scr, lane); }
    return (it0 + nitems) % NGW;
}
struct RmId { __device__ __forceinline__ int operator()(int) const { return 0; } };
struct RmWin { __device__ __forceinline__ int operator()(int n0) const { const int seg = n0 >> 11; const int os = seg < 4 ? seg : (seg == 4 ? 6 : seg - 1); return (os - seg) * 2048; } };
struct RmGu { int up; __device__ __forceinline__ int operator()(int n0) const { const int c = n0; return 256 * (c >> 7) + (c & 127) + 128 * up - c; } };

template <bool OUT32>
__device__ __forceinline__ void norm_row(const float* xrow, const f32x4 (&g)[8], void* orow, int lane) {
    const f32x4* xr = (const f32x4*)xrow + lane;
    f32x4 v[8]; float s = 0.f;
#pragma unroll
    for (int j = 0; j < 8; ++j) { v[j] = xr[64 * j]; s += (v[j][0] * v[j][0] + v[j][1] * v[j][1]) + (v[j][2] * v[j][2] + v[j][3] * v[j][3]); }
    const float rs = 1.0f / sqrtf(wave_sum(s) * (1.f / D) + RMS_EPS);
    if (OUT32) { f32x4* o = (f32x4*)orow + lane;
#pragma unroll
        for (int j = 0; j < 8; ++j) o[64 * j] = v[j] * rs * g[j];
    } else { u32x2* o = (u32x2*)orow + lane;
#pragma unroll
        for (int j = 0; j < 8; ++j) { const f32x4 y = v[j] * rs * g[j]; u32x2 w; w.x = pk2(y[0], y[1]); w.y = pk2(y[2], y[3]); o[64 * j] = w; }
    }
}
template <bool OUT32>
__device__ __forceinline__ void norm_rows(const float* src, const float* gain, void* dst, int nrows, int gw, int NGW, int lane_) {
    int lane = lane_; asm volatile("" : "+v"(lane));
    f32x4 g[8];
#pragma unroll
    for (int j = 0; j < 8; ++j) g[j] = ((const f32x4*)gain)[lane + 64 * j];
    for (int r = gw; r < nrows; r += NGW) norm_row<OUT32>(src + (size_t)r * D, g, OUT32 ? (void*)((float*)dst + (size_t)r * D) : (void*)((bf16_t*)dst + (size_t)r * D), lane);
}

constexpr int ATT_KB = 0, ATT_VB = 49152, ATT_KM = 98304;
template <bool MOBA>
__device__ __forceinline__ void attn_unit(LAS unsigned char* lds, const bf16_t* Qp, int qpitch, const bf16_t* Kp, int kpitch, const bf16_t* VTp, int vtpitch,
                                          bf16_t* Op, int opitch, int ntiles, int j, const float* kmean_bh, int nostore = 0) {
    int tid_l = threadIdx.x; asm volatile("" : "+v"(tid_l));
    const int tid = tid_l, lane = tid & 63, w = __builtin_amdgcn_readfirstlane(tid >> 6), ql = lane & 31, h2 = lane >> 5;
#define ATT_LOAD(i, b) do { _Pragma("unroll") for (int _i = 0; _i < 2; ++_i) { \
        __builtin_amdgcn_global_load_lds((const unsigned*)((const char*)Kp + (size_t)(64 * (i)) * kpitch * 2 + kg[_i]), (LAS unsigned*)(lds + ATT_KB + (b) * 16384 + (2 * w + _i) * 1024), 16, 0, 0); \
        __builtin_amdgcn_global_load_lds((const unsigned*)((const char*)VTp + (size_t)(64 * (i)) * 2 + vg[_i]), (LAS unsigned*)(lds + ATT_VB + (b) * 16384 + (2 * w + _i) * 1024), 16, 0, 0); } } while (0)
#define ATT_WAITBAR(n) do { asm volatile("s_waitcnt vmcnt(" #n ") lgkmcnt(0)" ::: "memory"); __builtin_amdgcn_s_barrier(); asm volatile("" ::: "memory"); } while (0)
    {
        unsigned kg[2], vg[2];
#pragma unroll
    for (int i = 0; i < 2; ++i) { const int pp = (2 * w + i) * 64 + lane; const int kr = pp >> 4, kc = (pp & 15) ^ (kr & 15), vr = pp >> 3, vc = (pp & 7) ^ ((vr >> 1) & 7);
        kg[i] = (unsigned)(kr * kpitch + kc * 8) * 2u; vg[i] = (unsigned)(vr * vtpitch + vc * 8) * 2u; }
    asm volatile("s_waitcnt vmcnt(0)" ::: "memory");
    ATT_LOAD(0, 0);
    if (ntiles > 1) ATT_LOAD(1, 1);
    }
    bf16x8 qf[8];
    { const bf16_t* qr = Qp + (size_t)(32 * w + ql) * qpitch + 8 * h2;
#pragma unroll
      for (int ks = 0; ks < 8; ++ks) qf[ks] = *(const bf16x8*)(qr + 16 * ks); }
    unsigned selmask = 0xffffffffu;
    if (MOBA) {
        if (j > 3) {
            LAS float* KM = (LAS float*)(lds + ATT_KM);
            for (int i = tid; i < j * 128; i += 512) KM[i] = kmean_bh[(size_t)(i >> 7) * D + (i & 127)];
            __syncthreads();
            float g[15];
#pragma unroll
            for (int kb = 0; kb < 15; ++kb) {
                float s = -INFINITY;
                if (kb < j) {
                    s = 0.f;
#pragma unroll
                    for (int ks = 0; ks < 8; ++ks) {
                        const f32x4 k0 = *(const LAS f32x4*)(KM + kb * 128 + 16 * ks + 8 * h2), k1 = *(const LAS f32x4*)(KM + kb * 128 + 16 * ks + 8 * h2 + 4);
                        const u32x4 qq = __builtin_bit_cast(u32x4, qf[ks]);
                        s += bflo(qq.x) * k0[0] + bfhi(qq.x) * k0[1] + bflo(qq.y) * k0[2] + bfhi(qq.y) * k0[3] + bflo(qq.z) * k1[0] + bfhi(qq.z) * k1[1] + bflo(qq.w) * k1[2] + bfhi(qq.w) * k1[3];
                    }
                    s += __shfl_xor(s, 32);
                }
                g[kb] = s;
            }
            selmask = 0u;
#pragma unroll
            for (int kb = 0; kb < 15; ++kb) {
                int cnt = 0;
#pragma unroll
                for (int k2 = 0; k2 < 15; ++k2) if (k2 != kb) cnt += (g[k2] > g[kb] || (g[k2] == g[kb] && k2 < kb)) ? 1 : 0;
                if (kb < j && cnt < 3) selmask |= (1u << kb);
            }
        }
    }
    const int kkey = (ql & 19) | ((ql & 4) << 1) | ((ql & 8) >> 1);
    const unsigned kbase = (unsigned)(kkey * 256 + ((h2 ^ (kkey & 15)) << 4));
    const unsigned vbase = (unsigned)(ql * 128 + ((h2 ^ ((ql >> 1) & 7)) << 4));
    int lane_s = lane; asm volatile("" : "+v"(lane_s));
    unsigned kg[2], vg[2];
#pragma unroll
    for (int i = 0; i < 2; ++i) { const int pp = (2 * w + i) * 64 + lane_s; const int kr = pp >> 4, kc = (pp & 15) ^ (kr & 15), vr = pp >> 3, vc = (pp & 7) ^ ((vr >> 1) & 7);
        kg[i] = (unsigned)(kr * kpitch + kc * 8) * 2u; vg[i] = (unsigned)(vr * vtpitch + vc * 8) * 2u; }
    f32x16 ot[4];
#pragma unroll
    for (int dt = 0; dt < 4; ++dt)
#pragma unroll
        for (int r = 0; r < 16; ++r) ot[dt][r] = 0.f;
    float mrow = NEGBIG, lsum = 0.f;
    ATT_WAITBAR(0);
    int b = 0;
#pragma unroll 1
    for (int i = 0; i < ntiles; ++i) {
        const int b2 = (b == 0) ? 2 : b - 1;
        if (i + 2 < ntiles) ATT_LOAD(i + 2, b2);
        bool need = true, selme = true; int kt = 0; bool own = false;
        if (MOBA) {
            if (i < 4 * j) { selme = (selmask >> (i >> 2)) & 1u; need = __builtin_amdgcn_ballot_w64(selme) != 0ull; }
            else { own = true; kt = i - 4 * j; need = kt <= (w >> 1); }
        }
        if (need) {
            const LAS unsigned char* kb_ = lds + ATT_KB + b * 16384;
            const LAS unsigned char* vb_ = lds + ATT_VB + b * 16384;
            f32x16 st[2];
            bf16x8 ka[8];
#pragma unroll
            for (int ks = 0; ks < 8; ++ks) ka[ks] = *(const LAS bf16x8*)(kb_ + (kbase ^ (unsigned)(ks << 5)));
            bf16x8 va[2][4];
#pragma unroll
            for (int dt = 0; dt < 4; ++dt) va[0][dt] = *(const LAS bf16x8*)(vb_ + dt * 4096 + vbase);
#pragma unroll
            for (int rt = 0; rt < 2; ++rt)
#pragma unroll
                for (int r = 0; r < 16; ++r) st[rt][r] = 0.f;
            __builtin_amdgcn_sched_barrier(0);
            __builtin_amdgcn_s_setprio(1);
#pragma unroll
            for (int ks = 0; ks < 8; ++ks) { st[0] = __builtin_amdgcn_mfma_f32_32x32x16_bf16(ka[ks], qf[ks], st[0], 0, 0, 0);
                ka[ks] = *(const LAS bf16x8*)(kb_ + 8192 + (kbase ^ (unsigned)(ks << 5))); __builtin_amdgcn_sched_barrier(0); }
#pragma unroll
            for (int ks = 0; ks < 8; ++ks) st[1] = __builtin_amdgcn_mfma_f32_32x32x16_bf16(ka[ks], qf[ks], st[1], 0, 0, 0);
            __builtin_amdgcn_s_setprio(0);
            if (MOBA) {
                if (own && 64 * kt + 63 > 32 * w) {
                    const int qloc = 32 * w + ql;
#pragma unroll
                    for (int rt = 0; rt < 2; ++rt)
#pragma unroll
                        for (int r = 0; r < 16; ++r) { const int key = 64 * kt + 32 * rt + 16 * (r >> 3) + 8 * h2 + (r & 7); if (key > qloc) st[rt][r] = NEGBIG; }
                }
            }
            float mx = st[0][0];
#pragma unroll
            for (int rt = 0; rt < 2; ++rt)
#pragma unroll
                for (int r = 0; r < 16; ++r) mx = fmaxf(mx, st[rt][r]);
            if (MOBA) mx = selme ? mx : NEGBIG;
            mx = fmaxf(mx, __shfl_xor(mx, 32));
            if (__builtin_amdgcn_ballot_w64(mx > mrow + 8.0f) != 0ull) {
                const float mnew = fmaxf(mrow, mx), alpha = __builtin_amdgcn_exp2f(mrow - mnew);
                mrow = mnew; lsum *= alpha;
#pragma unroll
                for (int dt = 0; dt < 4; ++dt)
#pragma unroll
                    for (int r = 0; r < 16; ++r) ot[dt][r] *= alpha;
            }
            const float msub = (MOBA && !selme) ? 1e30f : mrow;
            float ps = 0.f;
#pragma unroll
            for (int rt = 0; rt < 2; ++rt)
#pragma unroll
                for (int r = 0; r < 16; ++r) { const float p = __builtin_amdgcn_exp2f(st[rt][r] - msub); st[rt][r] = p; ps += p; }
            lsum += ps;
#pragma unroll
            for (int kk = 0; kk < 4; ++kk) {
                const int rt = kk >> 1, s = kk & 1;
                u32x4 pw; pw.x = pk2(st[rt][8 * s + 0], st[rt][8 * s + 1]); pw.y = pk2(st[rt][8 * s + 2], st[rt][8 * s + 3]); pw.z = pk2(st[rt][8 * s + 4], st[rt][8 * s + 5]); pw.w = pk2(st[rt][8 * s + 6], st[rt][8 * s + 7]);
                const bf16x8 pb = __builtin_bit_cast(bf16x8, pw);
                if (kk < 3) {
#pragma unroll
                    for (int dt = 0; dt < 4; ++dt) va[(kk + 1) & 1][dt] = *(const LAS bf16x8*)(vb_ + dt * 4096 + (vbase ^ (unsigned)((kk + 1) << 5)));
                }
                __builtin_amdgcn_s_setprio(1);
#pragma unroll
                for (int dt = 0; dt < 4; ++dt) ot[dt] = __builtin_amdgcn_mfma_f32_32x32x16_bf16(va[kk & 1][dt], pb, ot[dt], 0, 0, 0);
                __builtin_amdgcn_s_setprio(0);
                __builtin_amdgcn_sched_barrier(0);
            }
        }
        if (i + 2 < ntiles) ATT_WAITBAR(4); else ATT_WAITBAR(0);
        b = (b == 2) ? 0 : b + 1;
    }
#undef ATT_LOAD
#undef ATT_WAITBAR
    lsum += __shfl_xor(lsum, 32);
    const float inv = 1.f / lsum;
    if (nostore && inv != 1234.5f) return;
    int lq = ql; asm volatile("" : "+v"(lq));
    bf16_t* obase = Op + (unsigned)((32 * w + lq) * opitch + 8 * h2);
#pragma unroll
    for (int dt = 0; dt < 4; ++dt)
#pragma unroll
        for (int gp = 0; gp < 2; ++gp) {
            const int g0 = 2 * gp, g1 = 2 * gp + 1;
            unsigned ax = pk2(ot[dt][4 * g0] * inv, ot[dt][4 * g0 + 1] * inv), ay = pk2(ot[dt][4 * g0 + 2] * inv, ot[dt][4 * g0 + 3] * inv);
            unsigned bx_ = pk2(ot[dt][4 * g1] * inv, ot[dt][4 * g1 + 1] * inv), by_ = pk2(ot[dt][4 * g1 + 2] * inv, ot[dt][4 * g1 + 3] * inv);
            { auto r = __builtin_amdgcn_permlane32_swap(ax, bx_, false, false); ax = r[0]; bx_ = r[1]; }
            { auto r = __builtin_amdgcn_permlane32_swap(ay, by_, false, false); ay = r[0]; by_ = r[1]; }
            u32x4 o; o.x = ax; o.y = ay; o.z = bx_; o.w = by_;
            *(u32x4*)(obase + 32 * dt + 16 * gp) = o;
        }
}

__device__ __forceinline__ void conv_prepass(const bf16_t* XR, bf16_t* Y, const float* conv_w, const float* conv_b, int gt, int GT) {
    const int cg = gt & 255, chb = 8 * cg;
    float cw[4][8], cb[8];
#pragma unroll
    for (int e = 0; e < 8; ++e) { cb[e] = conv_b[chb + e];
#pragma unroll
        for (int k = 0; k < 4; ++k) cw[k][e] = conv_w[k * D + chb + e]; }
#pragma unroll 1
    for (int item = gt; item < (T / 8) * 256; item += GT) {
        const int t0 = (item >> 8) * 8, s0 = t0 & (SEQ - 1);
        u32x4 x[11];
#pragma unroll
        for (int i = 0; i < 11; ++i) x[i] = (i >= 3 || s0 != 0) ? *(const u32x4*)(XR + (size_t)(t0 - 3 + i) * D + chb) : (u32x4){0u, 0u, 0u, 0u};
#pragma unroll
        for (int i = 0; i < 8; ++i) {
            float y[8];
#pragma unroll
            for (int e = 0; e < 8; ++e) y[e] = cb[e];
#pragma unroll
            for (int k = 0; k < 4; ++k) { const u32x4 v = x[i + k];
                y[0] += cw[k][0] * bflo(v.x); y[1] += cw[k][1] * bfhi(v.x); y[2] += cw[k][2] * bflo(v.y); y[3] += cw[k][3] * bfhi(v.y);
                y[4] += cw[k][4] * bflo(v.z); y[5] += cw[k][5] * bfhi(v.z); y[6] += cw[k][6] * bflo(v.w); y[7] += cw[k][7] * bfhi(v.w); }
            u32x4 o; o.x = pk2(y[0], y[1]); o.y = pk2(y[2], y[3]); o.z = pk2(y[4], y[5]); o.w = pk2(y[6], y[7]);
            *(u32x4*)(Y + (size_t)(t0 + i) * D + chb) = o;
        }
    }
}
constexpr int RN_AU = 0, RN_HS = 16384;
struct RnnP { const bf16_t* Y; const bf16_t* GY; bf16_t* GYO; const bf16_t* Wa_t; const bf16_t* Wi_t; const float* b_a; const float* b_i; const float* lam; };
__device__ __forceinline__ void rnn_unit(LAS unsigned char* lds, const RnnP& P, int b, int n, int jq) {
    int tid_l = threadIdx.x; asm volatile("" : "+v"(tid_l));
    const int tid = tid_l, lane = tid & 63, w = __builtin_amdgcn_readfirstlane(tid >> 6);
    const int rt = w >> 1, ct = w & 1, l15 = lane & 15, l4 = lane >> 4;
    bf16x8 bfa[4], bfi[4];
    { const size_t wo = ((size_t)n * 128 + 32 * jq + 16 * ct + l15) * 128 + 8 * l4;
#pragma unroll
      for (int ks = 0; ks < 4; ++ks) { bfa[ks] = *(const bf16x8*)(P.Wa_t + wo + 32 * ks); bfi[ks] = *(const bf16x8*)(P.Wi_t + wo + 32 * ks); } }
    const int chj = n * 128 + 32 * jq + 16 * ct + l15;
    const float ba = P.b_a[chj], bi = P.b_i[chj];
    const float sp8 = 8.f * 1.4426950408889634f * log1pf(expf(-P.lam[chj]));
    float hstate = 0.f;
    const size_t rowbase = (size_t)b * SEQ;
    const bf16_t* yap = P.Y + (rowbase + 16 * rt + l15) * D + n * 128 + 8 * l4;
    const bf16_t* yvp = P.Y + (rowbase + 16 * rt + 4 * l4) * D + chj;
    const size_t gyo0 = (rowbase + (tid >> 3)) * D + n * 128 + 32 * jq + 4 * (tid & 7);
#define RN_BAR() do { asm volatile("s_waitcnt lgkmcnt(0)" ::: "memory"); __builtin_amdgcn_s_barrier(); asm volatile("" ::: "memory"); } while (0)
#define RN_LOAD(ya, yv, gy, t0) do { _Pragma("unroll") for (int ks = 0; ks < 4; ++ks) ya[ks] = *(const bf16x8*)(yap + (size_t)(t0) * D + 32 * ks); \
        _Pragma("unroll") for (int r = 0; r < 4; ++r) yv[r] = *(const unsigned short*)(yvp + (size_t)((t0) + r) * D); gy = *(const u32x2*)(P.GY + gyo0 + (size_t)(t0) * D); } while (0)
    bf16x8 yac[4], yan[4]; unsigned short yvc[4], yvn[4]; u32x2 gyc, gyn;
    RN_LOAD(yac, yvc, gyc, 0);
#pragma unroll
    for (int ks = 0; ks < 4; ++ks) yan[ks] = yac[ks];
#pragma unroll
    for (int r = 0; r < 4; ++r) yvn[r] = yvc[r];
    gyn = gyc;
#pragma unroll 1
    for (int st = 0; st < SEQ / 64; ++st) {
        const int t0 = st * 64;
        if (st + 1 < SEQ / 64) RN_LOAD(yan, yvn, gyn, t0 + 64);
        {
            f32x4 ar = (f32x4){0.f, 0.f, 0.f, 0.f}, ai = ar;
#pragma unroll
            for (int ks = 0; ks < 4; ++ks) { ar = __builtin_amdgcn_mfma_f32_16x16x32_bf16(yac[ks], bfa[ks], ar, 0, 0, 0); ai = __builtin_amdgcn_mfma_f32_16x16x32_bf16(yac[ks], bfi[ks], ai, 0, 0, 0); }
#pragma unroll
            for (int r = 0; r < 4; ++r) {
                const int tl = 16 * rt + 4 * l4 + r, jl = 16 * ct + l15;
                const float y = __builtin_bit_cast(float, (unsigned)yvc[r] << 16);
                const float rg = sigm(ar[r] + ba), ig = sigm(ai[r] + bi);
                const float log_a = -sp8 * rg;
                const float a = __builtin_amdgcn_exp2f(log_a), mult = __builtin_amdgcn_sqrtf(fmaxf(1.f - a * a, 0.f));
                f32x2 au; au.x = a; au.y = mult * (ig * y);
                *(LAS f32x2*)(lds + RN_AU + (tl * 32 + jl) * 8) = au;
            }
        }
        RN_BAR();
        if (tid < 64) {
            const int ch = tid & 31, hf = tid >> 5;
            float L = 0.f, Pc = 1.f, Lv[32], Pv[32];
#pragma unroll
            for (int c = 0; c < 2; ++c) {
                f32x2 au[16];
#pragma unroll
                for (int t = 0; t < 16; ++t) au[t] = *(const LAS f32x2*)(lds + RN_AU + ((32 * hf + 16 * c + t) * 32 + ch) * 8);
#pragma unroll
                for (int t = 0; t < 16; ++t) { Pc *= au[t].x; L = au[t].x * L + au[t].y; Lv[16 * c + t] = L; Pv[16 * c + t] = Pc; }
            }
            const float Llo = __shfl(L, ch), Plo = __shfl(Pc, ch);
            const float carry = hf ? (Llo + Plo * hstate) : hstate;
            float hl = 0.f;
#pragma unroll
            for (int t = 0; t < 32; ++t) { hl = Lv[t] + Pv[t] * carry; *(LAS float*)(lds + RN_HS + ((32 * hf + t) * 32 + ch) * 4) = hl; }
            hstate = __shfl(hl, 32 + ch);
        }
        RN_BAR();
        {
            const f32x4 h4 = *(const LAS f32x4*)(lds + RN_HS + ((tid >> 3) * 32 + 4 * (tid & 7)) * 4);
            u32x2 o; o.x = pk2(bflo(gyc.x) * h4[0], bfhi(gyc.x) * h4[1]); o.y = pk2(bflo(gyc.y) * h4[2], bfhi(gyc.y) * h4[3]);
            *(u32x2*)(P.GYO + gyo0 + (size_t)t0 * D) = o;
        }
#pragma unroll
        for (int ks = 0; ks < 4; ++ks) yac[ks] = yan[ks];
#pragma unroll
        for (int r = 0; r < 4; ++r) yvc[r] = yvn[r];
        gyc = gyn;
    }
#undef RN_BAR
#undef RN_LOAD
    __syncthreads();
}

#define XB_TMO      128
#define XB_XCNT(j)  (256  + 64 * (j))
#define XB_XSUB(j)  (1280 + 64 * (j))
#define XB_XGEN(j)  (2304 + 64 * (j))
#define XB_TOP      3328
#define XB_TOPGEN   3392
#define XCD_BAR_WORDS 3456
#define XB_SPIN_CAP (1u << 18)

__device__ __forceinline__ unsigned xb_ld(unsigned* p)              { return __hip_atomic_load(p, __ATOMIC_RELAXED, __HIP_MEMORY_SCOPE_AGENT); }
__device__ __forceinline__ unsigned xb_add(unsigned* p, unsigned v) { return __hip_atomic_fetch_add(p, v, __ATOMIC_RELAXED, __HIP_MEMORY_SCOPE_AGENT); }
__device__ __forceinline__ unsigned xb_xcc_id() { return (unsigned)__builtin_amdgcn_s_getreg((3 << 11) | 20) & 0xFu; }
#define XB_SPIN(cond, bar) do { unsigned _sp = 0; while (cond) { __builtin_amdgcn_s_sleep(1); \
    if ((++_sp & 255u) == 0u) { if (xb_ld(&(bar)[XB_TMO])) break; if (_sp > XB_SPIN_CAP) { atomicAdd(&(bar)[XB_TMO], 1u); break; } } } } while (0)

struct XcdBarrier {
    unsigned* bar; unsigned x;
    volatile LAS unsigned* st;
};

__device__ __forceinline__ XcdBarrier xcd_barrier_post(unsigned* bar, volatile LAS unsigned* st) {
    XcdBarrier b; b.bar = bar; b.x = xb_xcc_id(); b.st = st;
    if (threadIdx.x == 0) (void)xb_add(&bar[XB_XCNT(b.x)], 1u);
    return b;
}
__device__ __forceinline__ void xcd_barrier_complete(unsigned* bar, unsigned x, unsigned& nloc, unsigned& nx) {
    const unsigned G = gridDim.x * gridDim.y * gridDim.z;
    unsigned sum, cnt, mine, sp = 0u;
    for (;;) {
        sum = 0u; cnt = 0u; mine = 0u;
#pragma unroll
        for (unsigned j = 0; j < 16; ++j) { const unsigned c = xb_ld(&bar[XB_XCNT(j)]); sum += c; cnt += (c > 0u) ? 1u : 0u; mine = (j == x) ? c : mine; }
        if (sum == G) break;
        __builtin_amdgcn_s_sleep(1);
        if ((++sp & 255u) == 0u) { if (xb_ld(&bar[XB_TMO])) break; if (sp > XB_SPIN_CAP) { atomicAdd(&bar[XB_TMO], 1u); break; } }
    }
    nloc = mine > 0u ? mine : 1u; nx = cnt > 0u ? cnt : 1u;
}

__device__ __forceinline__ void xcd_barrier(const XcdBarrier& b) {
    asm volatile("s_waitcnt vmcnt(0)" ::: "memory");
    __syncthreads();
    if (threadIdx.x == 0) {
        unsigned* bar = b.bar;
        __builtin_amdgcn_s_waitcnt(0);
        unsigned nloc = b.st[0], nx = b.st[1];
        if (nloc == 0u) { xcd_barrier_complete(bar, b.x, nloc, nx); b.st[0] = nloc; b.st[1] = nx; }
        const unsigned old = xb_add(&bar[XB_XSUB(b.x)], 1u);
        const unsigned gen = old / nloc;
        if (old + 1u == (gen + 1u) * nloc) {
            __builtin_amdgcn_fence(__ATOMIC_RELEASE, "agent");
            asm volatile("s_waitcnt vmcnt(0)" ::: "memory");
            const unsigned og = xb_add(&bar[XB_TOP], 1u);
            const unsigned tg = og / nx;
            if (og + 1u == (tg + 1u) * nx) xb_add(&bar[XB_TOPGEN], 1u);
            else XB_SPIN(xb_ld(&bar[XB_TOPGEN]) == tg, bar);
            __builtin_amdgcn_fence(__ATOMIC_ACQUIRE, "agent");
            xb_add(&bar[XB_XGEN(b.x)], 1u);
            asm volatile("s_waitcnt vmcnt(0)" ::: "memory");
        } else {
            XB_SPIN(xb_ld(&bar[XB_XGEN(b.x)]) == gen, bar);
            __builtin_amdgcn_fence(__ATOMIC_ACQUIRE, "agent");
            asm volatile("s_waitcnt vmcnt(0)" ::: "memory");
        }
    }
    __syncthreads();
}

struct Args {
    const float* x; const float* mem; const int* pos; const float* norm_mix_g; const float* w_in; const float* conv_w; const float* conv_b;
    const float* lru_w_a; const float* lru_b_a; const float* lru_w_i; const float* lru_b_i; const float* lru_lambda;
    const float* w_rnn_proj; const float* w_attn_proj; const float* w_mix_out; const float* norm_xq_g; const float* norm_mem_g;
    const float* w_xq; const float* w_xkv; const float* w_xo; const float* norm_ffn_g; const float* w_ffn_gate; const float* w_ffn_up; const float* w_ffn_down; const float* norm_final_g;
    float* out; unsigned char* ws; int ph_lo, ph_hi;
};
constexpr int NPHASE = 13;
#ifndef WGM_WIDE
#define WGM_WIDE 4
#endif
#ifndef WGM_NARROW
#define WGM_NARROW 2
#endif
#ifndef WGM_VT
#define WGM_VT 4
#endif
#ifndef MK_PER_PHASE
#define MK_PER_PHASE 0
#endif

__device__ __forceinline__ unsigned long long ldarg(unsigned off) {
    unsigned long long kp = (unsigned long long)__builtin_amdgcn_kernarg_segment_ptr(), v;
    asm volatile("s_load_dwordx2 %0, %1, %2\n\ts_waitcnt lgkmcnt(0)" : "=s"(v) : "s"(kp), "i"(off) : "memory");
    return v;
}
#define ARGF(field) ((const float*)ldarg((unsigned)__builtin_offsetof(Args, field)))
#define ARGI(field) ((const int*)ldarg((unsigned)__builtin_offsetof(Args, field)))


__global__ void __launch_bounds__(512, 2) fwd(Args a) {
    extern __shared__ __attribute__((aligned(16))) unsigned char lds_raw[];
    LAS unsigned char* lds = (LAS unsigned char*)lds_raw;
    __builtin_assume(__builtin_amdgcn_workitem_id_y() == 0); __builtin_assume(__builtin_amdgcn_workitem_id_z() == 0);
    cg::grid_group grid = cg::this_grid();
    const int tid = threadIdx.x, lane = tid & 63, wave = __builtin_amdgcn_readfirstlane(tid >> 6);
    const int G = gridDim.x, bx = blockIdx.x;
    const int vcu = (G % 8 == 0) ? (bx % 8) * (G / 8) + bx / 8 : bx;
    const int gw = vcu * 8 + wave, NGW = G * 8;
    unsigned char* ws = a.ws;
    bf16_t* Win_t = (bf16_t*)(ws + WS_WIN); bf16_t* Wgu_t = (bf16_t*)(ws + WS_WGU);
    bf16_t* Wa_t = (bf16_t*)(ws + WS_WGATE); bf16_t* Wi_t = (bf16_t*)(ws + WS_WGATE + 512 * 1024);
    bf16_t* Wrnn_t = (bf16_t*)(ws + WS_WRNN); bf16_t* Wattn_t = (bf16_t*)(ws + WS_WATTN); bf16_t* Wmix_t = (bf16_t*)(ws + WS_WMIX);
    bf16_t* Wxq_t = (bf16_t*)(ws + WS_WXQ); bf16_t* Wxkv_t = (bf16_t*)(ws + WS_WXKV); bf16_t* Wxo_t = (bf16_t*)(ws + WS_WXO); bf16_t* Wdown_t = (bf16_t*)(ws + WS_WDOWN);
    bf16_t* K2 = (bf16_t*)(ws + WS_K2); bf16_t* V2T = (bf16_t*)(ws + WS_V2T);
    float* KMEAN = (float*)(ws + WS_KMEAN); float2* CS = (float2*)(ws + WS_CS);
    bf16_t* MEMN = (bf16_t*)(ws + WS_MEMN); bf16_t* H = (bf16_t*)(ws + WS_H);
    bf16_t* XR = (bf16_t*)(ws + WS_XR); bf16_t* GY = (bf16_t*)(ws + WS_GY); bf16_t* Qb = (bf16_t*)(ws + WS_Q); bf16_t* Kb = (bf16_t*)(ws + WS_K); bf16_t* VT = (bf16_t*)(ws + WS_VT);
    bf16_t* ACT = (bf16_t*)(ws + WS_ACT); bf16_t* Q2 = (bf16_t*)(ws + WS_Q2); bf16_t* O2 = (bf16_t*)(ws + WS_O2); bf16_t* T1 = (bf16_t*)(ws + WS_T1);
    bf16_t* SGR = (bf16_t*)a.out; bf16_t* SGA = SGR + SEG_ELEMS;
    float* SSQ1 = (float*)ws; float* SSQ2 = SSQ1 + T;
    const int lo = a.ph_lo, hi = a.ph_hi;
#ifndef PHMASK
#define PHMASK 0xffff
#endif
#define IN(k) (((PHMASK >> (k)) & 1) && lo <= (k) && (k) < hi)
#define LANE_NOW() ({ int t_ = threadIdx.x; asm volatile("" : "+v"(t_)); t_ & 63; })
#define XBAR() do { XcdBarrier xb_; xb_.bar = (unsigned*)(ws + WS_XBAR); xb_.x = xb_xcc_id(); xb_.st = (volatile LAS unsigned*)(lds + LDS_XB_ST); xcd_barrier(xb_); } while (0)
#if MK_PER_PHASE
#define SEAM(k) do { } while (0)
#else
#define SEAM(k) do { if (IN(k) && IN((k) + 1)) { if ((k) == 0) { grid.sync(); (void)xcd_barrier_post((unsigned*)(ws + WS_XBAR), (volatile LAS unsigned*)(lds + LDS_XB_ST)); } else XBAR(); } } while (0)
#endif
#ifndef DUP_PHASE
#define DUP_PHASE -1
#endif
#ifndef DUP_PART
#define DUP_PART 7
#endif
#define REPS(k) ((DUP_PHASE == (k)) ? 2 : 1)
#define REPLOOP(k) for (int rep = 0; rep < REPS(k); ++rep)
#define REPSYNC() do { if (rep) XBAR(); } while (0)
    LAS float* scr = (LAS float*)(lds + wave * 16384);
    if (tid < 2) ((LAS unsigned*)(lds + LDS_XB_ST))[tid] = 0u;
    __syncthreads();

    if (IN(0)) REPLOOP(0) { REPSYNC();
        int it = 0;
        it = tr_matrix(ARGF(w_in), D, 14336, Win_t, RmWin{}, scr, lane, gw, NGW, it);
        it = tr_matrix(ARGF(w_rnn_proj), D, D, Wrnn_t, RmId{}, scr, lane, gw, NGW, it);
        it = tr_matrix(ARGF(w_attn_proj), D, D, Wattn_t, RmId{}, scr, lane, gw, NGW, it);
        it = tr_matrix(ARGF(w_mix_out), D, D, Wmix_t, RmId{}, scr, lane, gw, NGW, it);
        it = tr_matrix(ARGF(w_xq), D, DMEM, Wxq_t, RmId{}, scr, lane, gw, NGW, it);
        it = tr_matrix(ARGF(w_xkv), D, 2 * DMEM, Wxkv_t, RmId{}, scr, lane, gw, NGW, it);
        it = tr_matrix(ARGF(w_xo), DMEM, D, Wxo_t, RmId{}, scr, lane, gw, NGW, it);
        for (int blk = 0; blk < 16; ++blk) {
            it = tr_matrix(ARGF(lru_w_a) + blk * 16384, 128, 128, Wa_t + blk * 16384, RmId{}, scr, lane, gw, NGW, it);
            it = tr_matrix(ARGF(lru_w_i) + blk * 16384, 128, 128, Wi_t + blk * 16384, RmId{}, scr, lane, gw, NGW, it);
        }
        const int gt = vcu * 512 + tid, GT = G * 512;
        const int* posp = ARGI(pos);
        for (int i = gt; i < T * 16; i += GT) {
            const int t = i >> 4, f = i & 15;
            const float invf = powf(500000.0f, -(float)f * (1.0f / 16.0f));
            const float ang = (float)posp[t] * invf;
            double rev = (double)ang * 0.15915494309189535; rev -= rint(rev);
            float2 v; v.x = __builtin_amdgcn_cosf((float)rev); v.y = __builtin_amdgcn_sinf((float)rev);
            CS[i] = v;
        }
        for (int i = gt; i < 64 * D; i += GT) KMEAN[i] = 0.f;
        for (int i = gt; i < 2 * T; i += GT) SSQ1[i] = 0.f;
        if (bx == 0) for (int i = tid; i < XCD_BAR_WORDS; i += 512) ((unsigned*)(ws + WS_XBAR))[i] = 0u;
        norm_rows<false>(ARGF(x), ARGF(norm_mix_g), H, T, gw, NGW, lane);
        norm_rows<false>(ARGF(mem), ARGF(norm_mem_g), MEMN, NB * MEML, gw, NGW, lane);
    }
    SEAM(0);
    if (IN(1)) REPLOOP(1) { REPSYNC();
        if (rep == REPS(1) - 1 || (DUP_PART & 1)) { Gemm g{H, Win_t, T, NIN1, D}; StaticOrder S; S.init(T, NIN1, G, bx, WGM_WIDE); EpiInProj E{XR, SGR, CS, KMEAN};
          gemm_phase<EpiInProj, StaticOrder, true, true>(lds, g, S, E); }
        if (rep == REPS(1) - 1 || (DUP_PART & 2)) { Gemm g{Win_t + (size_t)NIN1 * D, H, D, T, D}; StaticOrder S; S.init(D, T, G, bx, WGM_VT); EpiStore E{VT, T, 1.f};
          gemm_phase<EpiStore, StaticOrder, true, true>(lds, g, S, E); }
    }
    SEAM(1);
#define P2_BODY(OOUT, PARTS, NOST) do { \
        if ((PARTS) & 1) conv_prepass(XR, H, ARGF(conv_w), ARGF(conv_b), vcu * 512 + tid, G * 512); \
        if (vcu < 256 && ((PARTS) & 2)) { const int bh = vcu >> 2, sub = vcu & 3, b = bh >> 4, h = bh & 15; \
            _Pragma("unroll 1") for (int ui = 0; ui < 4; ++ui) { \
                const int j = (ui == 0) ? sub : (ui == 1) ? 7 - sub : (ui == 2) ? 8 + sub : 15 - sub; \
                const size_t qoff = ((size_t)b * SEQ + 256 * j) * D + h * HD; \
                attn_unit<true>(lds, Qb + qoff, D, Kb + (size_t)b * SEQ * D + h * HD, D, VT + (size_t)(h * HD) * T + (size_t)b * SEQ, T, (OOUT) + qoff, D, 4 * (j + 1), j, KMEAN + (size_t)(b * 16) * D + h * HD, (NOST)); } } \
        if ((PARTS) & 4) { int it = 0; \
          it = tr_matrix(ARGF(w_ffn_gate), D, DFF, Wgu_t, RmGu{0}, scr, LANE_NOW(), gw, NGW, it); \
          it = tr_matrix(ARGF(w_ffn_up), D, DFF, Wgu_t, RmGu{1}, scr, LANE_NOW(), gw, NGW, it); \
          (void)it; } } while (0)
    if (IN(2)) {
#if DUP_PHASE == 2
        P2_BODY(Qb, DUP_PART, 1); XBAR();
#endif
        P2_BODY(Qb, 7, 0);
    }
    if (IN(2)) XBAR();
    if (IN(2)) {
#if DUP_PHASE == 13
        if (vcu < 256) { RnnP P{H, GY, T1, Wa_t, Wi_t, ARGF(lru_b_a), ARGF(lru_b_i), ARGF(lru_lambda)}; rnn_unit(lds, P, vcu >> 6, (vcu >> 2) & 15, vcu & 3); }
        grid.sync();
#endif
        if (vcu < 256) { RnnP P{H, GY, GY, Wa_t, Wi_t, ARGF(lru_b_a), ARGF(lru_b_i), ARGF(lru_lambda)}; rnn_unit(lds, P, vcu >> 6, (vcu >> 2) & 15, vcu & 3); }
    }
    SEAM(2);
    if (IN(3)) REPLOOP(3) { REPSYNC();
        { Gemm g{GY, Wrnn_t, T, D, D, Qb, Wattn_t, D / 64}; StaticOrder S; S.init(T, D, G, bx, WGM_NARROW); EpiGate2 E{SGR, SGA, H};
          gemm_phase<EpiGate2, StaticOrder, true, true>(lds, g, S, E); }
    }
    SEAM(3);
    if (IN(4)) REPLOOP(4) { REPSYNC(); Gemm g{H, Wmix_t, T, D, D}; StaticOrder S; S.init(T, D, G, bx, WGM_NARROW); EpiResidNorm E{ARGF(x), a.out, GY, ARGF(norm_xq_g), SSQ1};
        gemm_phase<EpiResidNorm, StaticOrder, true, true>(lds, g, S, E); }
    SEAM(4);
#ifdef EXTRA_SYNCS
    for (int es = 0; es < EXTRA_SYNCS; ++es) grid.sync();
#endif
    if (IN(6)) REPLOOP(6) { REPSYNC();
        { Gemm g{GY, Wxq_t, T, DMEM, D}; StaticOrder S; S.init(T, DMEM, G, bx); EpiStoreRS E{Q2, DMEM, QSCALE, SSQ1};
          gemm_phase<EpiStoreRS, StaticOrder, true, true>(lds, g, S, E); }
        { Gemm g{MEMN, Wxkv_t, NB * MEML, DMEM, D}; StaticOrder S; S.init(NB * MEML, DMEM, G, (bx + G - 128 % G) % G); EpiStore E{K2, DMEM, 1.f};
          gemm_phase<EpiStore, StaticOrder, true, true>(lds, g, S, E); }
        { Gemm g{Wxkv_t + (size_t)DMEM * D, MEMN, DMEM, NB * MEML, D}; StaticOrder S; S.init(DMEM, NB * MEML, G, (bx + G - 136 % G) % G); EpiStore E{V2T, NB * MEML, 1.f};
          gemm_phase<EpiStore, StaticOrder, true, true>(lds, g, S, E); }
        if (bx >= 144) (void)tr_matrix(ARGF(w_ffn_down), DFF, D, Wdown_t, RmId{}, scr, LANE_NOW(), (bx - 144) * 8 + wave, (G - 144) * 8, 0);
    }
    SEAM(6);
    if (IN(7)) REPLOOP(7) { REPSYNC();
#ifndef P7_REPS
#define P7_REPS 1
#endif
        for (int r7 = 0; r7 < P7_REPS; ++r7)
        for (int u0 = vcu; u0 < 256; u0 += G) { const int u = (u0 + 64 * r7 + 16 * r7 + r7) & 255; const int b = u >> 6, mh = (u >> 4) & 3, qb = u & 15;
            const size_t qoff = ((size_t)b * SEQ + 256 * qb) * DMEM + mh * HD;
            attn_unit<true>(lds, Q2 + qoff, DMEM, K2 + (size_t)(b * MEML) * DMEM + mh * HD, DMEM, V2T + (size_t)(mh * HD) * (NB * MEML) + b * MEML, NB * MEML, O2 + qoff, DMEM, 4, 1, nullptr); }
    }
    SEAM(7);
    if (IN(8)) { Gemm g{O2, Wxo_t, T, D, DMEM}; StaticOrder S; S.init(T, D, G, bx, WGM_NARROW); EpiResidNorm E{a.out, a.out, H, ARGF(norm_ffn_g), SSQ2};
        gemm_phase<EpiResidNorm, StaticOrder, true, true>(lds, g, S, E); }
    SEAM(8);
    if (IN(10)) REPLOOP(10) { REPSYNC(); Gemm g{H, Wgu_t, T, 2 * DFF, D}; StaticOrder S; S.init(T, 2 * DFF, G, bx, WGM_WIDE); EpiSwigluRS E{ACT, SSQ2};
        gemm_phase<EpiSwigluRS, StaticOrder, true, true>(lds, g, S, E); }
    SEAM(10);
    if (IN(11)) { Gemm g{ACT, Wdown_t, T, D, DFF}; StaticOrder S; S.init(T, D, G, bx, WGM_NARROW); EpiResid E{a.out, a.out};
        gemm_phase<EpiResid, StaticOrder, true, true>(lds, g, S, E); }
    SEAM(11);
    if (IN(12)) norm_rows<true>(a.out, ARGF(norm_final_g), a.out, T, gw, NGW, LANE_NOW());
#undef IN
#undef SEAM
}

extern "C" void kernel_launch(void* const* d_in, const int* in_sizes, int n_in, void* d_out, int out_size, void* d_ws, size_t ws_size, hipStream_t stream) {
    static int grid = 0;
    if (grid == 0) {
        if (n_in != 25 || out_size != T * D || ws_size < WS_END) { fprintf(stderr, "kernel_launch: unexpected problem (n_in %d out %d ws %zu)\n", n_in, out_size, ws_size); grid = -1; return; }
        int dev = 0, cus = 0, per_cu = 0;
        (void)hipGetDevice(&dev);
        (void)hipDeviceGetAttribute(&cus, hipDeviceAttributeMultiprocessorCount, dev);
        (void)hipFuncSetAttribute((const void*)fwd, hipFuncAttributeMaxDynamicSharedMemorySize, LDS_BYTES);
        (void)hipOccupancyMaxActiveBlocksPerMultiprocessor(&per_cu, (const void*)fwd, 512, LDS_BYTES);
        fprintf(stderr, "kernel_launch: cus %d per_cu %d ws %zu\n", cus, per_cu, ws_size);
        grid = cus > 256 ? 256 : cus;
        if (grid != 256) fprintf(stderr, "kernel_launch: expected 256 CUs, got %d\n", cus);
    }
    if (grid < 0) return;
    Args a{};
    a.x = (const float*)d_in[0]; a.mem = (const float*)d_in[1]; a.pos = (const int*)d_in[2]; a.norm_mix_g = (const float*)d_in[3]; a.w_in = (const float*)d_in[4];
    a.conv_w = (const float*)d_in[5]; a.conv_b = (const float*)d_in[6]; a.lru_w_a = (const float*)d_in[7]; a.lru_b_a = (const float*)d_in[8]; a.lru_w_i = (const float*)d_in[9];
    a.lru_b_i = (const float*)d_in[10]; a.lru_lambda = (const float*)d_in[11]; a.w_rnn_proj = (const float*)d_in[12]; a.w_attn_proj = (const float*)d_in[13]; a.w_mix_out = (const float*)d_in[14];
    a.norm_xq_g = (const float*)d_in[15]; a.norm_mem_g = (const float*)d_in[16]; a.w_xq = (const float*)d_in[17]; a.w_xkv = (const float*)d_in[18]; a.w_xo = (const float*)d_in[19];
    a.norm_ffn_g = (const float*)d_in[20]; a.w_ffn_gate = (const float*)d_in[21]; a.w_ffn_up = (const float*)d_in[22]; a.w_ffn_down = (const float*)d_in[23]; a.norm_final_g = (const float*)d_in[24];
    a.out = (float*)d_out; a.ws = (unsigned char*)d_ws;
#if MK_PER_PHASE
    for (int ph = 0; ph < NPHASE; ++ph) {
        a.ph_lo = ph; a.ph_hi = ph + 1; void* args[] = {&a};
        hipError_t e = hipLaunchCooperativeKernel((const void*)fwd, dim3(grid), dim3(512), args, LDS_BYTES, stream);
        if (e != hipSuccess) { fprintf(stderr, "launch %d failed: %s\n", ph, hipGetErrorString(e)); break; }
    }
#else
    a.ph_lo = 0; a.ph_hi = NPHASE; void* args[] = {&a};
    hipError_t e = hipLaunchCooperativeKernel((const void*)fwd, dim3(grid), dim3(512), args, LDS_BYTES, stream);
    if (e != hipSuccess) fprintf(stderr, "cooperative launch failed: %s (grid %d)\n", hipGetErrorString(e), grid);
#endif
}
```

```cpp
#include <hip/hip_runtime.h>
#include <hip/hip_cooperative_groups.h>
#include <cstdio>
#include <cstdint>
namespace cg = cooperative_groups;
namespace pg8 {
#define PG8_LAS __attribute__((address_space(3)))
typedef unsigned short bf16_t;
typedef short bf16x8 __attribute__((ext_vector_type(8)));
typedef float f32x4 __attribute__((ext_vector_type(4)));
typedef unsigned u32x4 __attribute__((ext_vector_type(4)));
constexpr int BM = 256, BK = 64, HALF = 128, HTB = HALF * BK * 2  , STAGE_BYTES = 8 * HTB, NXCD = 8, WGM = 4;

__host__ __device__ __forceinline__ int lds_byte(int r, int c) { const int st = (r >> 4) * 2 + (c >> 5), rr = r & 15, cc = c & 31, ob = rr * 64 + cc * 2; return st * 1024 + (ob ^ (((ob >> 9) & 1) << 5)); }
__host__ __device__ __forceinline__ void stage_rc(int b, int& R, int& C) { const int st = b / 1024, sb = b % 1024, swz = sb ^ (((sb >> 9) & 1) << 5); R = (st >> 1) * 16 + swz / 64; C = (st & 1) * 32 + (swz % 64) / 2; }
__host__ __device__ __forceinline__ int perm32(int rho) { const int n = rho >> 4, i = rho & 15; return 8 * (i >> 2) + 4 * n + (i & 3); }

struct Unit { int pm, pn; };
struct Gemm { const bf16_t* A; const bf16_t* Bt; int M, N, K; const bf16_t* A2 = nullptr; const bf16_t* Bt2 = nullptr; int nt2 = 0; };

struct StaticOrder {
    int nM, nN, nwg, G, c, wgm;
    __host__ __device__ void init(int M, int N, int G_, int c_, int wgm_ = WGM) { nM = M / BM; nN = N / BM; nwg = nM * nN; G = G_; c = c_; wgm = wgm_; }
    __host__ __device__ bool next(int i, Unit& u) const {
        const long L = (long)i * G + c; if (L >= nwg) return false;
        int wgid = (int)L; { const int q = nwg / NXCD, r = nwg % NXCD, xcd = wgid % NXCD, off = wgid / NXCD; wgid = (xcd < r ? xcd * (q + 1) : r * (q + 1) + (xcd - r) * q) + off; }
        const int nig = wgm * nN, gid = wgid / nig, fm = gid * wgm, gsz = (nM - fm) < wgm ? (nM - fm) : wgm;
        u.pm = fm + ((wgid % nig) % gsz); u.pn = (wgid % nig) / gsz; return true;
    }
    __device__ __forceinline__ void a_ready(const Unit&) const {}
    __device__ __forceinline__ void done(const Unit&) const {}
};

__device__ __forceinline__ unsigned cvt_pk_bf16(float lo, float hi) { unsigned r; asm volatile("v_cvt_pk_bf16_f32 %0, %1, %2" : "=v"(r) : "v"(lo), "v"(hi)); return r; }
typedef float f32x2 __attribute__((ext_vector_type(2)));
template <class E, class = void> struct HasMid { static constexpr bool value = false; };
template <class E> struct HasMid<E, decltype((void)E::HAS_MID)> { static constexpr bool value = true; };
template <class Epi, class Sched, bool ALIGN_EPI = false, bool SP2 = false>
__device__ __forceinline__ void gemm_phase(PG8_LAS unsigned char* lds, const Gemm g, const Sched& S, const Epi& E) {
    int tid_l = threadIdx.x; asm volatile("" : "+v"(tid_l));
    const int tid = tid_l, wid = __builtin_amdgcn_readfirstlane(tid >> 6), lane = tid & 63, wr = wid >> 2, wc = wid & 3, fr = lane & 15, fq = lane >> 4;
    const int K = g.K, ns = K / BK, nt = ns + g.nt2;
    unsigned voffA[2], voffB[2];
#pragma unroll
    for (int i = 0; i < 2; ++i) { int R, C; stage_rc(tid * 16 + i * 8192, R, C); const int Rb = Epi::PERM ? ((R & ~31) + perm32(R & 31)) : R;
        voffA[i] = (unsigned)(R * K + C) * 2u; voffB[i] = (unsigned)(Rb * K + C) * 2u; }
    const size_t kstep = (size_t)(BK * 2);
    const size_t hstep = (size_t)HALF * K * 2;
    const size_t tstep = 2 * hstep;
    const unsigned ldsw = (unsigned)wid * 1024u;
    const int aoff = lds_byte(wr * 64 + fr, fq * 8), boff = lds_byte(wc * 32 + fr, fq * 8);
#define PG8_SA(b, h) (((b) * 2 + (h)) * HTB)
#define PG8_SB(b, h) ((4 + (b) * 2 + (h)) * HTB)
#ifndef PG8_AUX_A
#define PG8_AUX_A 0
#endif
#ifndef PG8_AUX_B
#define PG8_AUX_B 0
#endif
#define PG8_STAGE_X(bufoff, gbase, voff, AUX) do { _Pragma("unroll") for (int _i = 0; _i < 2; ++_i) \
        __builtin_amdgcn_global_load_lds((const unsigned*)((const char*)(gbase) + (voff)[_i]), (PG8_LAS unsigned*)(lds + (bufoff) + ldsw + _i * 8192), 16, 0, AUX); } while (0)
#define PG8_STAGEA(bufoff, gbase, voff) PG8_STAGE_X(bufoff, gbase, voff, PG8_AUX_A)
#define PG8_STAGEB(bufoff, gbase, voff) PG8_STAGE_X(bufoff, gbase, voff, PG8_AUX_B)
#define PG8_LDA(dst, b, h) do { _Pragma("unroll") for (int m = 0; m < 4; ++m) _Pragma("unroll") for (int k = 0; k < 2; ++k) dst[m][k] = *(const PG8_LAS bf16x8*)(lds + PG8_SA(b, h) + aoff + m * 2048 + k * 1024); } while (0)
#define PG8_LDB(dst, b, h) do { _Pragma("unroll") for (int n = 0; n < 2; ++n) _Pragma("unroll") for (int k = 0; k < 2; ++k) dst[n][k] = *(const PG8_LAS bf16x8*)(lds + PG8_SB(b, h) + boff + n * 2048 + k * 1024); } while (0)
#define PG8_MMA(ai, bj, At, Bt) do { __builtin_amdgcn_s_setprio(1); _Pragma("unroll") for (int m = 0; m < 4; ++m) _Pragma("unroll") for (int n = 0; n < 2; ++n) _Pragma("unroll") for (int k = 0; k < 2; ++k) \
        acc[ai][bj][m][n] = __builtin_amdgcn_mfma_f32_16x16x32_bf16(Bt[n][k], At[m][k], acc[ai][bj][m][n], 0, 0, 0); __builtin_amdgcn_s_setprio(0); } while (0)
#define PG8_WAIT_V(n) asm volatile("s_waitcnt vmcnt(" #n ")" ::: "memory")
#define PG8_WAIT_L(n) asm volatile("s_waitcnt lgkmcnt(" #n ")" ::: "memory")
#define PG8_BAR __builtin_amdgcn_s_barrier()
#define PG8_SCHED __builtin_amdgcn_sched_barrier(0)
    Unit cur, nxt; int ui = 0;
    if (!S.next(0, cur)) return;
    f32x4 acc[2][2][4][2];
#pragma unroll
    for (int a = 0; a < 2; ++a)
#pragma unroll
        for (int b = 0; b < 2; ++b)
#pragma unroll
            for (int m = 0; m < 4; ++m)
#pragma unroll
                for (int n = 0; n < 2; ++n) acc[a][b][m][n] = (f32x4){0.f, 0.f, 0.f, 0.f};
    bf16x8 At[4][2], B0[2][2], B1[2][2];
    const char* cA = (const char*)g.A + (size_t)cur.pm * tstep; const char* cB = (const char*)g.Bt + (size_t)cur.pn * tstep;
    const char* cA2 = g.nt2 ? (const char*)g.A2 + (size_t)cur.pm * tstep - (size_t)ns * (BK * 2) : cA; const char* cB2 = g.nt2 ? (const char*)g.Bt2 + (size_t)cur.pn * tstep - (size_t)ns * (BK * 2) : cB;
    S.a_ready(cur);
    if constexpr (SP2) {
        PG8_STAGEB(PG8_SB(0, 0), cB, voffB); PG8_STAGEB(PG8_SB(0, 1), cB + hstep, voffB); PG8_STAGEA(PG8_SA(0, 0), cA, voffA); PG8_STAGEA(PG8_SA(0, 1), cA + hstep, voffA);
        if (wr == 1) PG8_BAR;
        PG8_WAIT_V(2); PG8_BAR;
        PG8_STAGEB(PG8_SB(1, 0), cB + kstep, voffB); PG8_STAGEA(PG8_SA(1, 0), cA + kstep, voffA); PG8_STAGEB(PG8_SB(1, 1), cB + hstep + kstep, voffB);
        PG8_WAIT_V(6); PG8_BAR;
    } else {
        PG8_STAGEB(PG8_SB(0, 0), cB, voffB); PG8_STAGEA(PG8_SA(0, 0), cA, voffA); PG8_STAGEB(PG8_SB(0, 1), cB + hstep, voffB); PG8_STAGEA(PG8_SA(0, 1), cA + hstep, voffA);
        if (wr == 1) PG8_BAR;
        PG8_WAIT_V(4); PG8_BAR;
        PG8_STAGEB(PG8_SB(1, 0), cB + kstep, voffB); PG8_STAGEA(PG8_SA(1, 0), cA + kstep, voffA); PG8_STAGEB(PG8_SB(1, 1), cB + hstep + kstep, voffB);
        PG8_WAIT_V(6); PG8_BAR;
    }
    for (;;) {
        const bool has_next = S.next(ui + 1, nxt);
        const char* nA = has_next ? (const char*)g.A + (size_t)nxt.pm * tstep : cA; const char* nB = has_next ? (const char*)g.Bt + (size_t)nxt.pn * tstep : cB;
        const char* nA2 = (has_next && g.nt2) ? (const char*)g.A2 + (size_t)nxt.pm * tstep - (size_t)ns * (BK * 2) : cA2; const char* nB2 = (has_next && g.nt2) ? (const char*)g.Bt2 + (size_t)nxt.pn * tstep - (size_t)ns * (BK * 2) : cB2;
        for (int t = 0; t < nt; t += 2) {
            const bool last = (t == nt - 2);
            if constexpr (HasMid<Epi>::value) { if (t == ns) E.mid(acc, cur, wr, wc, fr, fq); }
            const char* sA1 = (t + 1 >= ns) ? cA2 : cA; const char* sA2 = (t + 2 >= ns) ? cA2 : cA; const char* sB2 = (t + 2 >= ns) ? cB2 : cB;
            const char* a1 = sA1 + (size_t)(t + 1) * kstep;
            const char* a2 = last ? nA : sA2 + (size_t)(t + 2) * kstep; const char* b2 = last ? nB : sB2 + (size_t)(t + 2) * kstep;
            const char* a3 = a2 + kstep; const char* b3 = b2 + kstep;
            if (last && has_next) S.a_ready(nxt);
            if constexpr (SP2) {
            PG8_LDB(B0, 0, 0); PG8_LDB(B1, 0, 1); PG8_SCHED; PG8_LDA(At, 0, 0); PG8_STAGEA(PG8_SA(1, 1), a1 + hstep, voffA);
            PG8_WAIT_V(8); PG8_WAIT_L(0); PG8_BAR; PG8_MMA(0, 0, At, B0); PG8_MMA(0, 1, At, B1); PG8_BAR; PG8_SCHED;
            PG8_LDA(At, 0, 1); PG8_STAGEB(PG8_SB(0, 0), b2, voffB); PG8_STAGEB(PG8_SB(0, 1), b2 + hstep, voffB); PG8_STAGEA(PG8_SA(0, 0), a2, voffA);
            PG8_WAIT_V(8); PG8_WAIT_L(0); PG8_BAR; PG8_MMA(1, 0, At, B0); PG8_MMA(1, 1, At, B1); PG8_BAR; PG8_SCHED;
            PG8_LDB(B0, 1, 0); PG8_LDB(B1, 1, 1); PG8_SCHED; PG8_LDA(At, 1, 0); PG8_STAGEA(PG8_SA(0, 1), a2 + hstep, voffA);
            PG8_WAIT_V(8); PG8_WAIT_L(0); PG8_BAR; PG8_MMA(0, 0, At, B0); PG8_MMA(0, 1, At, B1); PG8_BAR; PG8_SCHED;
            PG8_LDA(At, 1, 1); PG8_STAGEB(PG8_SB(1, 0), b3, voffB); PG8_STAGEB(PG8_SB(1, 1), b3 + hstep, voffB); PG8_STAGEA(PG8_SA(1, 0), a3, voffA);
            PG8_WAIT_V(8); PG8_WAIT_L(0); PG8_BAR; PG8_MMA(1, 0, At, B0); PG8_MMA(1, 1, At, B1); PG8_BAR; PG8_SCHED;
            } else {
            PG8_LDB(B0, 0, 0); PG8_SCHED; PG8_LDA(At, 0, 0); PG8_STAGEA(PG8_SA(1, 1), a1 + hstep, voffA);
            PG8_WAIT_L(8); PG8_BAR; PG8_WAIT_L(0); PG8_MMA(0, 0, At, B0); PG8_BAR; PG8_SCHED;
            PG8_LDB(B1, 0, 1); PG8_STAGEB(PG8_SB(0, 0), b2, voffB);
            PG8_BAR; PG8_WAIT_L(0); PG8_MMA(0, 1, At, B1); PG8_BAR;
            PG8_LDA(At, 0, 1); PG8_STAGEA(PG8_SA(0, 0), a2, voffA);
            PG8_BAR; PG8_WAIT_L(0); PG8_MMA(1, 0, At, B0); PG8_BAR; PG8_SCHED;
            PG8_STAGEB(PG8_SB(0, 1), b2 + hstep, voffB);
            PG8_WAIT_V(6); PG8_BAR; PG8_MMA(1, 1, At, B1); PG8_BAR;
            PG8_LDB(B0, 1, 0); PG8_SCHED; PG8_LDA(At, 1, 0); PG8_STAGEA(PG8_SA(0, 1), a2 + hstep, voffA);
            PG8_WAIT_L(8); PG8_BAR; PG8_WAIT_L(0); PG8_MMA(0, 0, At, B0); PG8_BAR; PG8_SCHED;
            PG8_LDB(B1, 1, 1); PG8_STAGEB(PG8_SB(1, 0), b3, voffB);
            PG8_BAR; PG8_WAIT_L(0); PG8_MMA(0, 1, At, B1); PG8_BAR;
            PG8_LDA(At, 1, 1); PG8_STAGEA(PG8_SA(1, 0), a3, voffA);
            PG8_BAR; PG8_WAIT_L(0); PG8_MMA(1, 0, At, B0); PG8_BAR; PG8_SCHED;
            PG8_STAGEB(PG8_SB(1, 1), b3 + hstep, voffB);
            PG8_WAIT_V(6); PG8_BAR; PG8_MMA(1, 1, At, B1); PG8_BAR;
            }
        }
        if constexpr (ALIGN_EPI) { if (wr == 0) PG8_BAR; }
        if constexpr (!Epi::AFTER_DRAIN) { E(acc, cur, wr, wc, fr, fq); S.done(cur); }
        if (!has_next) break;
#pragma unroll
        for (int a = 0; a < 2; ++a)
#pragma unroll
            for (int b = 0; b < 2; ++b)
#pragma unroll
                for (int m = 0; m < 4; ++m)
#pragma unroll
                    for (int n = 0; n < 2; ++n) acc[a][b][m][n] = (f32x4){0.f, 0.f, 0.f, 0.f};
        cur = nxt; cA = nA; cB = nB; cA2 = nA2; cB2 = nB2; ++ui;
        if constexpr (ALIGN_EPI) { if (wr == 1) PG8_BAR; }
    }
    PG8_WAIT_V(0);
    if constexpr (!ALIGN_EPI) { if (wr == 0) PG8_BAR; }
    PG8_BAR;
    if constexpr (Epi::AFTER_DRAIN) { E.fused(acc, cur, wr, wc, fr, fq, lds, wid, lane); S.done(cur); }
#undef PG8_SA
#undef PG8_SB
#undef PG8_STAGE_X
#undef PG8_STAGEA
#undef PG8_STAGEB
#undef PG8_LDA
#undef PG8_LDB
#undef PG8_MMA
#undef PG8_WAIT_V
#undef PG8_WAIT_L
#undef PG8_BAR
#undef PG8_SCHED
}
}

using namespace pg8;
#define LAS __attribute__((address_space(3)))
typedef float f32x16 __attribute__((ext_vector_type(16)));
typedef unsigned u32x2 __attribute__((ext_vector_type(2)));

constexpr int NB = 4, SEQ = 4096, T = NB * SEQ, D = 2048, NH = 16, HD = 128, DFF = 5632, MEML = 256, DMEM = 512;
constexpr int NIN1 = 12288;
constexpr float RMS_EPS = 1e-6f;
constexpr float QSCALE = 0.08838834764831845f * 1.4426950408889634f;
constexpr float NEGBIG = -1e30f;

constexpr size_t MiB = 1u << 20;
constexpr size_t WS_WIN = 1 * MiB;
constexpr size_t WS_WGU = WS_WIN;
constexpr size_t WS_WGATE = 57 * MiB;
constexpr size_t WS_WRNN = 58 * MiB, WS_WATTN = 66 * MiB, WS_WMIX = 74 * MiB;
constexpr size_t WS_WXQ = 82 * MiB;
constexpr size_t WS_WXKV = 84 * MiB;
constexpr size_t WS_WXO = 88 * MiB;
constexpr size_t WS_K2 = 90 * MiB;
constexpr size_t WS_V2T = 91 * MiB;
constexpr size_t WS_KMEAN = 92 * MiB;
constexpr size_t WS_CS = 93 * MiB;
constexpr size_t WS_MEMN = 95 * MiB;
constexpr size_t WS_H = 104 * MiB;
constexpr size_t WS_XR = 168 * MiB;
constexpr size_t WS_GY = 232 * MiB, WS_Q = 296 * MiB, WS_K = 360 * MiB;
constexpr size_t WS_VT = 424 * MiB;
constexpr size_t WS_WDOWN = 488 * MiB;
constexpr size_t WS_ACT = 168 * MiB;
constexpr size_t WS_Q2 = 360 * MiB, WS_O2 = 376 * MiB;
constexpr size_t WS_T1 = WS_XR;
constexpr size_t WS_END = 512 * MiB;
constexpr size_t SEG_ELEMS = (size_t)T * D;

constexpr int LDS_BYTES = 147456;
constexpr int LDS_XB_ST = 147392;
constexpr size_t WS_XBAR = 512 * 1024;

__device__ __forceinline__ unsigned f2bf(float f) { unsigned u = __builtin_bit_cast(unsigned, f); return (u + 0x7fffu + ((u >> 16) & 1u)) >> 16; }
__device__ __forceinline__ unsigned pk2(float lo, float hi) { return cvt_pk_bf16(lo, hi); }
__device__ __forceinline__ float bflo(unsigned w) { return __builtin_bit_cast(float, w << 16); }
__device__ __forceinline__ float bfhi(unsigned w) { return __builtin_bit_cast(float, w & 0xffff0000u); }
__device__ __forceinline__ float sigm(float x) { return __builtin_amdgcn_rcpf(1.f + __builtin_amdgcn_exp2f(-1.4426950408889634f * x)); }
__device__ __forceinline__ float gelu_tanh(float x) { return x * sigm(1.5957691216057308f * (x + 0.044715f * x * x * x)); }
__device__ __forceinline__ float wave_sum(float v) {
#pragma unroll
    for (int o = 1; o < 64; o <<= 1) v += __shfl_xor(v, o);
    return v;
}

__device__ __forceinline__ void st8(bf16_t* p, const f32x4& a, const f32x4& b) { u32x4 w; w.x = pk2(a[0], a[1]); w.y = pk2(a[2], a[3]); w.z = pk2(b[0], b[1]); w.w = pk2(b[2], b[3]); *(u32x4*)p = w; }

struct EpiInProj {
    static constexpr bool PERM = true, AFTER_DRAIN = false;
    bf16_t* act0; bf16_t* gate0; const float2* cs; float* kmean;
    __device__ __forceinline__ void operator()(const f32x4 (&acc)[2][2][4][2], const Unit& u, int wr, int wc, int fr, int fq) const {
        const int seg = u.pn >> 3, colt = (u.pn & 7) * 256;
        bf16_t* base = seg < 4 ? act0 + (size_t)seg * SEG_ELEMS : gate0 + (size_t)(seg - 4) * SEG_ELEMS;
        const int row0 = u.pm * 256 + wr * 64 + fr, col0 = colt + wc * 32 + 8 * fq;
        if (seg == 2 || seg == 3) {
            const bool roped = (wc == 0);
            const float sc = (seg == 2) ? QSCALE : 1.f;
            const float sgn = (fq < 2) ? -1.f : 1.f;
            f32x4 ks[2][2];
#pragma unroll
            for (int bj = 0; bj < 2; ++bj) { ks[bj][0] = (f32x4){0.f, 0.f, 0.f, 0.f}; ks[bj][1] = (f32x4){0.f, 0.f, 0.f, 0.f}; }
#pragma unroll
            for (int ai = 0; ai < 2; ++ai)
#pragma unroll
                for (int m = 0; m < 4; ++m) {
                    const int row = row0 + ai * 128 + m * 16;
                    f32x4 c0, s0, c1, s1;
                    if (roped) { const f32x4* cp = (const f32x4*)(cs + (size_t)row * 16 + 8 * (fq & 1));
                        const f32x4 t0 = cp[0], t1 = cp[1], t2 = cp[2], t3 = cp[3];
                        c0 = (f32x4){t0[0], t0[2], t1[0], t1[2]}; s0 = (f32x4){t0[1], t0[3], t1[1], t1[3]};
                        c1 = (f32x4){t2[0], t2[2], t3[0], t3[2]}; s1 = (f32x4){t2[1], t2[3], t3[1], t3[3]}; }
#pragma unroll
                    for (int bj = 0; bj < 2; ++bj) {
                        f32x4 v0 = acc[ai][bj][m][0], v1 = acc[ai][bj][m][1];
                        if (roped) {
                            f32x4 p0, p1;
#pragma unroll
                            for (int e = 0; e < 4; ++e) { p0[e] = __shfl_xor(v0[e], 32); p1[e] = __shfl_xor(v1[e], 32); }
                            v0 = v0 * c0 + (p0 * s0) * sgn; v1 = v1 * c1 + (p1 * s1) * sgn;
                        }
                        if (seg == 3) { ks[bj][0] += v0; ks[bj][1] += v1; }
                        st8(base + (size_t)row * D + col0 + bj * 128, v0 * sc, v1 * sc);
                    }
                }
            if (seg == 3) {
#pragma unroll
                for (int bj = 0; bj < 2; ++bj)
#pragma unroll
                    for (int n = 0; n < 2; ++n)
#pragma unroll
                        for (int e = 0; e < 4; ++e) { float s = ks[bj][n][e]; s += __shfl_xor(s, 1); s += __shfl_xor(s, 2); s += __shfl_xor(s, 4); s += __shfl_xor(s, 8);
                            if (fr == 0) atomicAdd(kmean + (size_t)u.pm * D + col0 + bj * 128 + 4 * n + e, s); }
            }
        } else {
#pragma unroll
            for (int ai = 0; ai < 2; ++ai)
#pragma unroll
                for (int m = 0; m < 4; ++m) {
                    const int row = row0 + ai * 128 + m * 16;
#pragma unroll
                    for (int bj = 0; bj < 2; ++bj) {
                        f32x4 v0 = acc[ai][bj][m][0], v1 = acc[ai][bj][m][1];
                        if (seg == 1) {
#pragma unroll
                            for (int e = 0; e < 4; ++e) { v0[e] = gelu_tanh(v0[e]); v1[e] = gelu_tanh(v1[e]); }
                        } else if (seg >= 4) {
#pragma unroll
                            for (int e = 0; e < 4; ++e) { v0[e] = sigm(v0[e]); v1[e] = sigm(v1[e]); }
                        }
                        st8(base + (size_t)row * D + col0 + bj * 128, v0, v1);
                    }
                }
        }
    }
};

struct EpiStore {
    static constexpr bool PERM = true, AFTER_DRAIN = false;
    bf16_t* O; int ldc; float sc;
    __device__ __forceinline__ void operator()(const f32x4 (&acc)[2][2][4][2], const Unit& u, int wr, int wc, int fr, int fq) const {
        const int row0 = u.pm * 256 + wr * 64 + fr, col0 = u.pn * 256 + wc * 32 + 8 * fq;
#pragma unroll
        for (int ai = 0; ai < 2; ++ai)
#pragma unroll
            for (int m = 0; m < 4; ++m) {
                bf16_t* rp = O + (size_t)(row0 + ai * 128 + m * 16) * ldc + col0;
#pragma unroll
                for (int bj = 0; bj < 2; ++bj) st8(rp + bj * 128, acc[ai][bj][m][0] * sc, acc[ai][bj][m][1] * sc);
            }
    }
};

struct EpiGate {
    static constexpr bool PERM = true, AFTER_DRAIN = false;
    const bf16_t* G; const bf16_t* P; bf16_t* O; int MODE;
    __device__ __forceinline__ void operator()(const f32x4 (&acc)[2][2][4][2], const Unit& u, int wr, int wc, int fr, int fq) const {
        const int row0 = u.pm * 256 + wr * 64 + fr, col0 = u.pn * 256 + wc * 32 + 8 * fq;
#pragma unroll
        for (int ai = 0; ai < 2; ++ai)
#pragma unroll
            for (int m = 0; m < 4; ++m) {
                const size_t off = (size_t)(row0 + ai * 128 + m * 16) * D + col0;
#pragma unroll
                for (int bj = 0; bj < 2; ++bj) {
                    const u32x4 g = *(const u32x4*)(G + off + bj * 128);
                    f32x4 v0 = acc[ai][bj][m][0], v1 = acc[ai][bj][m][1];
                    v0 = v0 * (f32x4){bflo(g.x), bfhi(g.x), bflo(g.y), bfhi(g.y)}; v1 = v1 * (f32x4){bflo(g.z), bfhi(g.z), bflo(g.w), bfhi(g.w)};
                    if (MODE == 1) { const u32x4 p = *(const u32x4*)(P + off + bj * 128);
                        v0 = v0 + (f32x4){bflo(p.x), bfhi(p.x), bflo(p.y), bfhi(p.y)}; v1 = v1 + (f32x4){bflo(p.z), bfhi(p.z), bflo(p.w), bfhi(p.w)}; }
                    st8(O + off + bj * 128, v0, v1);
                }
            }
    }
};

struct EpiGate2 {
    static constexpr bool PERM = true, AFTER_DRAIN = false, HAS_MID = true;
    const bf16_t* GR; const bf16_t* GA; bf16_t* O;
    __device__ __forceinline__ void mid(f32x4 (&acc)[2][2][4][2], const Unit& u, int wr, int wc, int fr, int fq) const {
        int row0 = u.pm * 256 + wr * 64 + fr; const int col0 = u.pn * 256 + wc * 32 + 8 * fq;
        asm volatile("" : "+v"(row0));
#pragma unroll
        for (int ai = 0; ai < 2; ++ai)
#pragma unroll
            for (int m = 0; m < 4; ++m) {
                asm volatile("" ::: "memory");
                const size_t off = (size_t)(row0 + ai * 128 + m * 16) * D + col0;
#pragma unroll
                for (int bj = 0; bj < 2; ++bj) {
                    const u32x4 r = *(const u32x4*)(GR + off + bj * 128), g = *(const u32x4*)(GA + off + bj * 128);
                    const f32x4 r0 = (f32x4){bflo(r.x), bfhi(r.x), bflo(r.y), bfhi(r.y)}, r1 = (f32x4){bflo(r.z), bfhi(r.z), bflo(r.w), bfhi(r.w)};
                    f32x4 q0, q1;
                    q0[0] = __builtin_amdgcn_rcpf(fmaxf(bflo(g.x), 1e-30f)); q0[1] = __builtin_amdgcn_rcpf(fmaxf(bfhi(g.x), 1e-30f)); q0[2] = __builtin_amdgcn_rcpf(fmaxf(bflo(g.y), 1e-30f)); q0[3] = __builtin_amdgcn_rcpf(fmaxf(bfhi(g.y), 1e-30f));
                    q1[0] = __builtin_amdgcn_rcpf(fmaxf(bflo(g.z), 1e-30f)); q1[1] = __builtin_amdgcn_rcpf(fmaxf(bfhi(g.z), 1e-30f)); q1[2] = __builtin_amdgcn_rcpf(fmaxf(bflo(g.w), 1e-30f)); q1[3] = __builtin_amdgcn_rcpf(fmaxf(bfhi(g.w), 1e-30f));
                    acc[ai][bj][m][0] = acc[ai][bj][m][0] * (r0 * q0); acc[ai][bj][m][1] = acc[ai][bj][m][1] * (r1 * q1);
                }
            }
    }
    __device__ __forceinline__ void operator()(const f32x4 (&acc)[2][2][4][2], const Unit& u, int wr, int wc, int fr, int fq) const {
        const int row0 = u.pm * 256 + wr * 64 + fr, col0 = u.pn * 256 + wc * 32 + 8 * fq;
#pragma unroll
        for (int ai = 0; ai < 2; ++ai)
#pragma unroll
            for (int m = 0; m < 4; ++m) {
                const size_t off = (size_t)(row0 + ai * 128 + m * 16) * D + col0;
#pragma unroll
                for (int bj = 0; bj < 2; ++bj) {
                    const u32x4 g = *(const u32x4*)(GA + off + bj * 128);
                    st8(O + off + bj * 128, acc[ai][bj][m][0] * (f32x4){bflo(g.x), bfhi(g.x), bflo(g.y), bfhi(g.y)}, acc[ai][bj][m][1] * (f32x4){bflo(g.z), bfhi(g.z), bflo(g.w), bfhi(g.w)});
                }
            }
    }
};

struct EpiSwiglu {
    static constexpr bool PERM = true, AFTER_DRAIN = false;
    bf16_t* O;
    __device__ __forceinline__ void operator()(const f32x4 (&acc)[2][2][4][2], const Unit& u, int wr, int wc, int fr, int fq) const {
        const int row0 = u.pm * 256 + wr * 64 + fr, col0 = u.pn * 128 + wc * 32 + 8 * fq;
#pragma unroll
        for (int ai = 0; ai < 2; ++ai)
#pragma unroll
            for (int m = 0; m < 4; ++m) {
                f32x4 v0, v1;
#pragma unroll
                for (int e = 0; e < 4; ++e) { const float g0 = acc[ai][0][m][0][e], g1 = acc[ai][0][m][1][e];
                    v0[e] = g0 * sigm(g0) * acc[ai][1][m][0][e]; v1[e] = g1 * sigm(g1) * acc[ai][1][m][1][e]; }
                st8(O + (size_t)(row0 + ai * 128 + m * 16) * DFF + col0, v0, v1);
            }
    }
};

struct EpiResid {
    static constexpr bool PERM = false, AFTER_DRAIN = false;
    const float* base; float* out;
    __device__ __forceinline__ void operator()(const f32x4 (&acc)[2][2][4][2], const Unit& u, int wr, int wc, int fr, int fq) const {
        const int row0 = u.pm * 256 + wr * 64 + fr, col0 = u.pn * 256 + wc * 32 + 4 * fq;
#pragma unroll
        for (int ai = 0; ai < 2; ++ai)
#pragma unroll
            for (int m = 0; m < 4; ++m) {
                const size_t off = (size_t)(row0 + ai * 128 + m * 16) * D + col0;
#pragma unroll
                for (int bj = 0; bj < 2; ++bj)
#pragma unroll
                    for (int n = 0; n < 2; ++n) { const f32x4 b = *(const f32x4*)(base + off + bj * 128 + n * 16); *(f32x4*)(out + off + bj * 128 + n * 16) = b + acc[ai][bj][m][n]; }
            }
    }
};

struct EpiResidNorm {
    static constexpr bool PERM = false, AFTER_DRAIN = false;
    const float* base; float* out; bf16_t* xg; const float* gain; float* ssq;
    __device__ __forceinline__ void operator()(const f32x4 (&acc)[2][2][4][2], const Unit& u, int wr, int wc, int fr, int fq) const {
        const int row0 = u.pm * 256 + wr * 64 + fr, col0 = u.pn * 256 + wc * 32 + 4 * fq;
        f32x4 gv[2][2];
#pragma unroll
        for (int bj = 0; bj < 2; ++bj)
#pragma unroll
            for (int n = 0; n < 2; ++n) gv[bj][n] = *(const f32x4*)(gain + col0 + bj * 128 + n * 16);
#pragma unroll
        for (int ai = 0; ai < 2; ++ai)
#pragma unroll
            for (int m = 0; m < 4; ++m) {
                const int row = row0 + ai * 128 + m * 16; const size_t off = (size_t)row * D + col0;
                float s = 0.f;
#pragma unroll
                for (int bj = 0; bj < 2; ++bj)
#pragma unroll
                    for (int n = 0; n < 2; ++n) { const f32x4 b = *(const f32x4*)(base + off + bj * 128 + n * 16); const f32x4 o = b + acc[ai][bj][m][n];
                        *(f32x4*)(out + off + bj * 128 + n * 16) = o; s += (o[0] * o[0] + o[1] * o[1]) + (o[2] * o[2] + o[3] * o[3]);
                        const f32x4 y = o * gv[bj][n]; u32x2 w; w.x = pk2(y[0], y[1]); w.y = pk2(y[2], y[3]); *(u32x2*)(xg + off + bj * 128 + n * 16) = w; }
                s += __shfl_xor(s, 16); s += __shfl_xor(s, 32);
                if (fq == 0) atomicAdd(ssq + row, s);
            }
    }
};
struct EpiStoreRS {
    static constexpr bool PERM = true, AFTER_DRAIN = false;
    bf16_t* O; int ldc; float sc; const float* ssq;
    __device__ __forceinline__ void operator()(const f32x4 (&acc)[2][2][4][2], const Unit& u, int wr, int wc, int fr, int fq) const {
        const int row0 = u.pm * 256 + wr * 64 + fr, col0 = u.pn * 256 + wc * 32 + 8 * fq;
#pragma unroll
        for (int ai = 0; ai < 2; ++ai)
#pragma unroll
            for (int m = 0; m < 4; ++m) {
                const int row = row0 + ai * 128 + m * 16; const float rs = sc * (1.0f / sqrtf(ssq[row] * (1.f / D) + RMS_EPS));
                bf16_t* rp = O + (size_t)row * ldc + col0;
#pragma unroll
                for (int bj = 0; bj < 2; ++bj) st8(rp + bj * 128, acc[ai][bj][m][0] * rs, acc[ai][bj][m][1] * rs);
            }
    }
};
struct EpiSwigluRS {
    static constexpr bool PERM = true, AFTER_DRAIN = false;
    bf16_t* O; const float* ssq;
    __device__ __forceinline__ void operator()(const f32x4 (&acc)[2][2][4][2], const Unit& u, int wr, int wc, int fr, int fq) const {
        const int row0 = u.pm * 256 + wr * 64 + fr, col0 = u.pn * 128 + wc * 32 + 8 * fq;
#pragma unroll
        for (int ai = 0; ai < 2; ++ai)
#pragma unroll
            for (int m = 0; m < 4; ++m) {
                const int row = row0 + ai * 128 + m * 16; const float rs = 1.0f / sqrtf(ssq[row] * (1.f / D) + RMS_EPS);
                f32x4 v0, v1;
#pragma unroll
                for (int e = 0; e < 4; ++e) { const float g0 = acc[ai][0][m][0][e] * rs, g1 = acc[ai][0][m][1][e] * rs;
                    v0[e] = g0 * sigm(g0) * (acc[ai][1][m][0][e] * rs); v1[e] = g1 * sigm(g1) * (acc[ai][1][m][1][e] * rs); }
                st8(O + (size_t)row * DFF + col0, v0, v1);
            }
    }
};

__device__ __forceinline__ void tr_item(const float* W, int K, int N, bf16_t* WT, int row_off, int k0, int n0, LAS unsigned char* scr, int lane) {
    const int ng = lane & 15, kg = lane >> 4;
    const float* src = W + (size_t)(k0 + 4 * kg) * N + n0 + 4 * ng;
    f32x4 v[4][4];
#pragma unroll
    for (int s = 0; s < 4; ++s)
#pragma unroll
        for (int j = 0; j < 4; ++j) v[s][j] = *(const f32x4*)(src + (size_t)(16 * s + j) * N);
#pragma unroll
    for (int s = 0; s < 4; ++s)
#pragma unroll
        for (int e = 0; e < 4; ++e) { u32x2 o; o.x = pk2(v[s][0][e], v[s][1][e]); o.y = pk2(v[s][2][e], v[s][3][e]);
            *(LAS u32x2*)(scr + (4 * ng + e) * 128 + (((2 * s + (kg >> 1)) ^ (ng & 7)) << 4) + (kg & 1) * 8) = o; }
    asm volatile("s_waitcnt lgkmcnt(0)" ::: "memory");
#pragma unroll
    for (int i = 0; i < 8; ++i) { const int n = 8 * i + (lane >> 3), c = lane & 7;
        const u32x4 o = *(const LAS u32x4*)(scr + n * 128 + ((c ^ ((n >> 2) & 7)) << 4));
        *(u32x4*)(WT + (size_t)(row_off + n0 + n) * K + k0 + 8 * c) = o; }
    asm volatile("s_waitcnt lgkmcnt(0)" ::: "memory");
}
template <class RowMap>
__device__ __forceinline__ int tr_matrix(const float* W, int K, int N, bf16_t* WT, RowMap rm, LAS float* scr, int lane_, int gw, int NGW, int it0) {
    int lane = lane_; asm volatile("" : "+v"(lane));
    const int nblk = N / 64, nitems = (K / 64) * nblk;
    int first = ((gw - it0) % NGW + NGW) % NGW;
    for (int it = first; it < nitems; it += NGW) { const int kb = it / nblk, nb = it % nblk; tr_item(W, K, N, WT, rm(nb * 64), kb * 64, nb * 64, (LAS unsigned char*)scr, lane); }
    return (it0 + nitems) % NGW;
}
struct RmId { __device__ __forceinline__ int operator()(int) const { return 0; } };
struct RmWin { __device__ __forceinline__ int operator()(int n0) const { const int seg = n0 >> 11; const int os = seg < 4 ? seg : (seg == 4 ? 6 : seg - 1); return (os - seg) * 2048; } };
struct RmGu { int up; __device__ __forceinline__ int operator()(int n0) const { const int c = n0; return 256 * (c >> 7) + (c & 127) + 128 * up - c; } };

template <bool OUT32>
__device__ __forceinline__ void norm_row(const float* xrow, const f32x4 (&g)[8], void* orow, int lane) {
    const f32x4* xr = (const f32x4*)xrow + lane;
    f32x4 v[8]; float s = 0.f;
#pragma unroll
    for (int j = 0; j < 8; ++j) { v[j] = xr[64 * j]; s += (v[j][0] * v[j][0] + v[j][1] * v[j][1]) + (v[j][2] * v[j][2] + v[j][3] * v[j][3]); }
    const float rs = 1.0f / sqrtf(wave_sum(s) * (1.f / D) + RMS_EPS);
    if (OUT32) { f32x4* o = (f32x4*)orow + lane;
#pragma unroll
        for (int j = 0; j < 8; ++j) o[64 * j] = v[j] * rs * g[j];
    } else { u32x2* o = (u32x2*)orow + lane;
#pragma unroll
        for (int j = 0; j < 8; ++j) { const f32x4 y = v[j] * rs * g[j]; u32x2 w; w.x = pk2(y[0], y[1]); w.y = pk2(y[2], y[3]); o[64 * j] = w; }
    }
}
template <bool OUT32>
__device__ __forceinline__ void norm_rows(const float* src, const float* gain, void* dst, int nrows, int gw, int NGW, int lane_) {
    int lane = lane_; asm volatile("" : "+v"(lane));
    f32x4 g[8];
#pragma unroll
    for (int j = 0; j < 8; ++j) g[j] = ((const f32x4*)gain)[lane + 64 * j];
    for (int r = gw; r < nrows; r += NGW) norm_row<OUT32>(src + (size_t)r * D, g, OUT32 ? (void*)((float*)dst + (size_t)r * D) : (void*)((bf16_t*)dst + (size_t)r * D), lane);
}

constexpr int ATT_KB = 0, ATT_VB = 49152, ATT_KM = 98304;
template <bool MOBA>
__device__ __forceinline__ void attn_unit(LAS unsigned char* lds, const bf16_t* Qp, int qpitch, const bf16_t* Kp, int kpitch, const bf16_t* VTp, int vtpitch,
                                          bf16_t* Op, int opitch, int ntiles, int j, const float* kmean_bh, int nostore = 0) {
    int tid_l = threadIdx.x; asm volatile("" : "+v"(tid_l));
    const int tid = tid_l, lane = tid & 63, w = __builtin_amdgcn_readfirstlane(tid >> 6), ql = lane & 31, h2 = lane >> 5;
#define ATT_LOAD(i, b) do { _Pragma("unroll") for (int _i = 0; _i < 2; ++_i) { \
        __builtin_amdgcn_global_load_lds((const unsigned*)((const char*)Kp + (size_t)(64 * (i)) * kpitch * 2 + kg[_i]), (LAS unsigned*)(lds + ATT_KB + (b) * 16384 + (2 * w + _i) * 1024), 16, 0, 0); \
        __builtin_amdgcn_global_load_lds((const unsigned*)((const char*)VTp + (size_t)(64 * (i)) * 2 + vg[_i]), (LAS unsigned*)(lds + ATT_VB + (b) * 16384 + (2 * w + _i) * 1024), 16, 0, 0); } } while (0)
#define ATT_WAITBAR(n) do { asm volatile("s_waitcnt vmcnt(" #n ") lgkmcnt(0)" ::: "memory"); __builtin_amdgcn_s_barrier(); asm volatile("" ::: "memory"); } while (0)
    {
        unsigned kg[2], vg[2];
#pragma unroll
    for (int i = 0; i < 2; ++i) { const int pp = (2 * w + i) * 64 + lane; const int kr = pp >> 4, kc = (pp & 15) ^ (kr & 15), vr = pp >> 3, vc = (pp & 7) ^ ((vr >> 1) & 7);
        kg[i] = (unsigned)(kr * kpitch + kc * 8) * 2u; vg[i] = (unsigned)(vr * vtpitch + vc * 8) * 2u; }
    asm volatile("s_waitcnt vmcnt(0)" ::: "memory");
    ATT_LOAD(0, 0);
    if (ntiles > 1) ATT_LOAD(1, 1);
    }
    bf16x8 qf[8];
    { const bf16_t* qr = Qp + (size_t)(32 * w + ql) * qpitch + 8 * h2;
#pragma unroll
      for (int ks = 0; ks < 8; ++ks) qf[ks] = *(const bf16x8*)(qr + 16 * ks); }
    unsigned selmask = 0xffffffffu;
    if (MOBA) {
        if (j > 3) {
            LAS float* KM = (LAS float*)(lds + ATT_KM);
            for (int i = tid; i < j * 128; i += 512) KM[i] = kmean_bh[(size_t)(i >> 7) * D + (i & 127)];
            __syncthreads();
            float g[15];
#pragma unroll
            for (int kb = 0; kb < 15; ++kb) {
                float s = -INFINITY;
                if (kb < j) {
                    s = 0.f;
#pragma unroll
                    for (int ks = 0; ks < 8; ++ks) {
                        const f32x4 k0 = *(const LAS f32x4*)(KM + kb * 128 + 16 * ks + 8 * h2), k1 = *(const LAS f32x4*)(KM + kb * 128 + 16 * ks + 8 * h2 + 4);
                        const u32x4 qq = __builtin_bit_cast(u32x4, qf[ks]);
                        s += bflo(qq.x) * k0[0] + bfhi(qq.x) * k0[1] + bflo(qq.y) * k0[2] + bfhi(qq.y) * k0[3] + bflo(qq.z) * k1[0] + bfhi(qq.z) * k1[1] + bflo(qq.w) * k1[2] + bfhi(qq.w) * k1[3];
                    }
                    s += __shfl_xor(s, 32);
                }
                g[kb] = s;
            }
            selmask = 0u;
#pragma unroll
            for (int kb = 0; kb < 15; ++kb) {
                int cnt = 0;
#pragma unroll
                for (int k2 = 0; k2 < 15; ++k2) if (k2 != kb) cnt += (g[k2] > g[kb] || (g[k2] == g[kb] && k2 < kb)) ? 1 : 0;
                if (kb < j && cnt < 3) selmask |= (1u << kb);
            }
        }
    }
    const int kkey = (ql & 19) | ((ql & 4) << 1) | ((ql & 8) >> 1);
    const unsigned kbase = (unsigned)(kkey * 256 + ((h2 ^ (kkey & 15)) << 4));
    const unsigned vbase = (unsigned)(ql * 128 + ((h2 ^ ((ql >> 1) & 7)) << 4));
    int lane_s = lane; asm volatile("" : "+v"(lane_s));
    unsigned kg[2], vg[2];
#pragma unroll
    for (int i = 0; i < 2; ++i) { const int pp = (2 * w + i) * 64 + lane_s; const int kr = pp >> 4, kc = (pp & 15) ^ (kr & 15), vr = pp >> 3, vc = (pp & 7) ^ ((vr >> 1) & 7);
        kg[i] = (unsigned)(kr * kpitch + kc * 8) * 2u; vg[i] = (unsigned)(vr * vtpitch + vc * 8) * 2u; }
    f32x16 ot[4];
#pragma unroll
    for (int dt = 0; dt < 4; ++dt)
#pragma unroll
        for (int r = 0; r < 16; ++r) ot[dt][r] = 0.f;
    float mrow = NEGBIG, lsum = 0.f;
    ATT_WAITBAR(0);
    int b = 0;
#pragma unroll 1
    for (int i = 0; i < ntiles; ++i) {
        const int b2 = (b == 0) ? 2 : b - 1;
        if (i + 2 < ntiles) ATT_LOAD(i + 2, b2);
        bool need = true, selme = true; int kt = 0; bool own = false;
        if (MOBA) {
            if (i < 4 * j) { selme = (selmask >> (i >> 2)) & 1u; need = __builtin_amdgcn_ballot_w64(selme) != 0ull; }
            else { own = true; kt = i - 4 * j; need = kt <= (w >> 1); }
        }
        if (need) {
            const LAS unsigned char* kb_ = lds + ATT_KB + b * 16384;
            const LAS unsigned char* vb_ = lds + ATT_VB + b * 16384;
            f32x16 st[2];
            bf16x8 ka[8];
#pragma unroll
            for (int ks = 0; ks < 8; ++ks) ka[ks] = *(const LAS bf16x8*)(kb_ + (kbase ^ (unsigned)(ks << 5)));
            bf16x8 va[2][4];
#pragma unroll
            for (int dt = 0; dt < 4; ++dt) va[0][dt] = *(const LAS bf16x8*)(vb_ + dt * 4096 + vbase);
#pragma unroll
            for (int rt = 0; rt < 2; ++rt)
#pragma unroll
                for (int r = 0; r < 16; ++r) st[rt][r] = 0.f;
            __builtin_amdgcn_sched_barrier(0);
            __builtin_amdgcn_s_setprio(1);
#pragma unroll
            for (int ks = 0; ks < 8; ++ks) { st[0] = __builtin_amdgcn_mfma_f32_32x32x16_bf16(ka[ks], qf[ks], st[0], 0, 0, 0);
                ka[ks] = *(const LAS bf16x8*)(kb_ + 8192 + (kbase ^ (unsigned)(ks << 5))); __builtin_amdgcn_sched_barrier(0); }
#pragma unroll
            for (int ks = 0; ks < 8; ++ks) st[1] = __builtin_amdgcn_mfma_f32_32x32x16_bf16(ka[ks], qf[ks], st[1], 0, 0, 0);
            __builtin_amdgcn_s_setprio(0);
            if (MOBA) {
                if (own && 64 * kt + 63 > 32 * w) {
                    const int qloc = 32 * w + ql;
#pragma unroll
                    for (int rt = 0; rt < 2; ++rt)
#pragma unroll
                        for (int r = 0; r < 16; ++r) { const int key = 64 * kt + 32 * rt + 16 * (r >> 3) + 8 * h2 + (r & 7); if (key > qloc) st[rt][r] = NEGBIG; }
                }
            }
            float mx = st[0][0];
#pragma unroll
            for (int rt = 0; rt < 2; ++rt)
#pragma unroll
                for (int r = 0; r < 16; ++r) mx = fmaxf(mx, st[rt][r]);
            if (MOBA) mx = selme ? mx : NEGBIG;
            mx = fmaxf(mx, __shfl_xor(mx, 32));
            if (__builtin_amdgcn_ballot_w64(mx > mrow + 8.0f) != 0ull) {
                const float mnew = fmaxf(mrow, mx), alpha = __builtin_amdgcn_exp2f(mrow - mnew);
                mrow = mnew; lsum *= alpha;
#pragma unroll
                for (int dt = 0; dt < 4; ++dt)
#pragma unroll
                    for (int r = 0; r < 16; ++r) ot[dt][r] *= alpha;
            }
            const float msub = (MOBA && !selme) ? 1e30f : mrow;
            float ps = 0.f;
#pragma unroll
            for (int rt = 0; rt < 2; ++rt)
#pragma unroll
                for (int r = 0; r < 16; ++r) { const float p = __builtin_amdgcn_exp2f(st[rt][r] - msub); st[rt][r] = p; ps += p; }
            lsum += ps;
#pragma unroll
            for (int kk = 0; kk < 4; ++kk) {
                const int rt = kk >> 1, s = kk & 1;
                u32x4 pw; pw.x = pk2(st[rt][8 * s + 0], st[rt][8 * s + 1]); pw.y = pk2(st[rt][8 * s + 2], st[rt][8 * s + 3]); pw.z = pk2(st[rt][8 * s + 4], st[rt][8 * s + 5]); pw.w = pk2(st[rt][8 * s + 6], st[rt][8 * s + 7]);
                const bf16x8 pb = __builtin_bit_cast(bf16x8, pw);
                if (kk < 3) {
#pragma unroll
                    for (int dt = 0; dt < 4; ++dt) va[(kk + 1) & 1][dt] = *(const LAS bf16x8*)(vb_ + dt * 4096 + (vbase ^ (unsigned)((kk + 1) << 5)));
                }
                __builtin_amdgcn_s_setprio(1);
#pragma unroll
                for (int dt = 0; dt < 4; ++dt) ot[dt] = __builtin_amdgcn_mfma_f32_32x32x16_bf16(va[kk & 1][dt], pb, ot[dt], 0, 0, 0);
                __builtin_amdgcn_s_setprio(0);
                __builtin_amdgcn_sched_barrier(0);
            }
        }
        if (i + 2 < ntiles) ATT_WAITBAR(4); else ATT_WAITBAR(0);
        b = (b == 2) ? 0 : b + 1;
    }
#undef ATT_LOAD
#undef ATT_WAITBAR
    lsum += __shfl_xor(lsum, 32);
    const float inv = 1.f / lsum;
    if (nostore && inv != 1234.5f) return;
    int lq = ql; asm volatile("" : "+v"(lq));
    bf16_t* obase = Op + (unsigned)((32 * w + lq) * opitch + 8 * h2);
#pragma unroll
    for (int dt = 0; dt < 4; ++dt)
#pragma unroll
        for (int gp = 0; gp < 2; ++gp) {
            const int g0 = 2 * gp, g1 = 2 * gp + 1;
            unsigned ax = pk2(ot[dt][4 * g0] * inv, ot[dt][4 * g0 + 1] * inv), ay = pk2(ot[dt][4 * g0 + 2] * inv, ot[dt][4 * g0 + 3] * inv);
            unsigned bx_ = pk2(ot[dt][4 * g1] * inv, ot[dt][4 * g1 + 1] * inv), by_ = pk2(ot[dt][4 * g1 + 2] * inv, ot[dt][4 * g1 + 3] * inv);
            { auto r = __builtin_amdgcn_permlane32_swap(ax, bx_, false, false); ax = r[0]; bx_ = r[1]; }
            { auto r = __builtin_amdgcn_permlane32_swap(ay, by_, false, false); ay = r[0]; by_ = r[1]; }
            u32x4 o; o.x = ax; o.y = ay; o.z = bx_; o.w = by_;
            *(u32x4*)(obase + 32 * dt + 16 * gp) = o;
        }
}

__device__ __forceinline__ void conv_prepass(const bf16_t* XR, bf16_t* Y, const float* conv_w, const float* conv_b, int gt, int GT) {
    const int cg = gt & 255, chb = 8 * cg;
    float cw[4][8], cb[8];
#pragma unroll
    for (int e = 0; e < 8; ++e) { cb[e] = conv_b[chb + e];
#pragma unroll
        for (int k = 0; k < 4; ++k) cw[k][e] = conv_w[k * D + chb + e]; }
#pragma unroll 1
    for (int item = gt; item < (T / 8) * 256; item += GT) {
        const int t0 = (item >> 8) * 8, s0 = t0 & (SEQ - 1);
        u32x4 x[11];
#pragma unroll
        for (int i = 0; i < 11; ++i) x[i] = (i >= 3 || s0 != 0) ? *(const u32x4*)(XR + (size_t)(t0 - 3 + i) * D + chb) : (u32x4){0u, 0u, 0u, 0u};
#pragma unroll
        for (int i = 0; i < 8; ++i) {
            float y[8];
#pragma unroll
            for (int e = 0; e < 8; ++e) y[e] = cb[e];
#pragma unroll
            for (int k = 0; k < 4; ++k) { const u32x4 v = x[i + k];
                y[0] += cw[k][0] * bflo(v.x); y[1] += cw[k][1] * bfhi(v.x); y[2] += cw[k][2] * bflo(v.y); y[3] += cw[k][3] * bfhi(v.y);
                y[4] += cw[k][4] * bflo(v.z); y[5] += cw[k][5] * bfhi(v.z); y[6] += cw[k][6] * bflo(v.w); y[7] += cw[k][7] * bfhi(v.w); }
            u32x4 o; o.x = pk2(y[0], y[1]); o.y = pk2(y[2], y[3]); o.z = pk2(y[4], y[5]); o.w = pk2(y[6], y[7]);
            *(u32x4*)(Y + (size_t)(t0 + i) * D + chb) = o;
        }
    }
}
constexpr int RN_AU = 0, RN_HS = 16384;
struct RnnP { const bf16_t* Y; const bf16_t* GY; bf16_t* GYO; const bf16_t* Wa_t; const bf16_t* Wi_t; const float* b_a; const float* b_i; const float* lam; };
__device__ __forceinline__ void rnn_unit(LAS unsigned char* lds, const RnnP& P, int b, int n, int jq) {
    int tid_l = threadIdx.x; asm volatile("" : "+v"(tid_l));
    const int tid = tid_l, lane = tid & 63, w = __builtin_amdgcn_readfirstlane(tid >> 6);
    const int rt = w >> 1, ct = w & 1, l15 = lane & 15, l4 = lane >> 4;
    bf16x8 bfa[4], bfi[4];
    { const size_t wo = ((size_t)n * 128 + 32 * jq + 16 * ct + l15) * 128 + 8 * l4;
#pragma unroll
      for (int ks = 0; ks < 4; ++ks) { bfa[ks] = *(const bf16x8*)(P.Wa_t + wo + 32 * ks); bfi[ks] = *(const bf16x8*)(P.Wi_t + wo + 32 * ks); } }
    const int chj = n * 128 + 32 * jq + 16 * ct + l15;
    const float ba = P.b_a[chj], bi = P.b_i[chj];
    const float sp8 = 8.f * 1.4426950408889634f * log1pf(expf(-P.lam[chj]));
    float hstate = 0.f;
    const size_t rowbase = (size_t)b * SEQ;
    const bf16_t* yap = P.Y + (rowbase + 16 * rt + l15) * D + n * 128 + 8 * l4;
    const bf16_t* yvp = P.Y + (rowbase + 16 * rt + 4 * l4) * D + chj;
    const size_t gyo0 = (rowbase + (tid >> 3)) * D + n * 128 + 32 * jq + 4 * (tid & 7);
#define RN_BAR() do { asm volatile("s_waitcnt lgkmcnt(0)" ::: "memory"); __builtin_amdgcn_s_barrier(); asm volatile("" ::: "memory"); } while (0)
#define RN_LOAD(ya, yv, gy, t0) do { _Pragma("unroll") for (int ks = 0; ks < 4; ++ks) ya[ks] = *(const bf16x8*)(yap + (size_t)(t0) * D + 32 * ks); \
        _Pragma("unroll") for (int r = 0; r < 4; ++r) yv[r] = *(const unsigned short*)(yvp + (size_t)((t0) + r) * D); gy = *(const u32x2*)(P.GY + gyo0 + (size_t)(t0) * D); } while (0)
    bf16x8 yac[4], yan[4]; unsigned short yvc[4], yvn[4]; u32x2 gyc, gyn;
    RN_LOAD(yac, yvc, gyc, 0);
#pragma unroll
    for (int ks = 0; ks < 4; ++ks) yan[ks] = yac[ks];
#pragma unroll
    for (int r = 0; r < 4; ++r) yvn[r] = yvc[r];
    gyn = gyc;
#pragma unroll 1
    for (int st = 0; st < SEQ / 64; ++st) {
        const int t0 = st * 64;
        if (st + 1 < SEQ / 64) RN_LOAD(yan, yvn, gyn, t0 + 64);
        {
            f32x4 ar = (f32x4){0.f, 0.f, 0.f, 0.f}, ai = ar;
#pragma unroll
            for (int ks = 0; ks < 4; ++ks) { ar = __builtin_amdgcn_mfma_f32_16x16x32_bf16(yac[ks], bfa[ks], ar, 0, 0, 0); ai = __builtin_amdgcn_mfma_f32_16x16x32_bf16(yac[ks], bfi[ks], ai, 0, 0, 0); }
#pragma unroll
            for (int r = 0; r < 4; ++r) {
                const int tl = 16 * rt + 4 * l4 + r, jl = 16 * ct + l15;
                const float y = __builtin_bit_cast(float, (unsigned)yvc[r] << 16);
                const float rg = sigm(ar[r] + ba), ig = sigm(ai[r] + bi);
                const float log_a = -sp8 * rg;
                const float a = __builtin_amdgcn_exp2f(log_a), mult = __builtin_amdgcn_sqrtf(fmaxf(1.f - a * a, 0.f));
                f32x2 au; au.x = a; au.y = mult * (ig * y);
                *(LAS f32x2*)(lds + RN_AU + (tl * 32 + jl) * 8) = au;
            }
        }
        RN_BAR();
        if (tid < 32) {
            float h = hstate;
            f32x2 au[16], aun[16];
#pragma unroll
            for (int t = 0; t < 16; ++t) au[t] = *(const LAS f32x2*)(lds + RN_AU + (t * 32 + tid) * 8);
#pragma unroll
            for (int c = 0; c < 4; ++c) {
                if (c < 3) {
#pragma unroll
                    for (int t = 0; t < 16; ++t) aun[t] = *(const LAS f32x2*)(lds + RN_AU + ((16 * (c + 1) + t) * 32 + tid) * 8);
                }
                float hv[16];
#pragma unroll
                for (int t = 0; t < 16; ++t) { h = au[t].x * h + au[t].y; hv[t] = h; }
#pragma unroll
                for (int t = 0; t < 16; ++t) *(LAS float*)(lds + RN_HS + ((16 * c + t) * 32 + tid) * 4) = hv[t];
#pragma unroll
                for (int t = 0; t < 16; ++t) au[t] = aun[t];
            }
            hstate = h;
        }
        RN_BAR();
        {
            const f32x4 h4 = *(const LAS f32x4*)(lds + RN_HS + ((tid >> 3) * 32 + 4 * (tid & 7)) * 4);
            u32x2 o; o.x = pk2(bflo(gyc.x) * h4[0], bfhi(gyc.x) * h4[1]); o.y = pk2(bflo(gyc.y) * h4[2], bfhi(gyc.y) * h4[3]);
            *(u32x2*)(P.GYO + gyo0 + (size_t)t0 * D) = o;
        }
#pragma unroll
        for (int ks = 0; ks < 4; ++ks) yac[ks] = yan[ks];
#pragma unroll
        for (int r = 0; r < 4; ++r) yvc[r] = yvn[r];
        gyc = gyn;
    }
#undef RN_BAR
#undef RN_LOAD
    __syncthreads();
}

#define XB_TMO      128
#define XB_XCNT(j)  (256  + 64 * (j))
#define XB_XSUB(j)  (1280 + 64 * (j))
#define XB_XGEN(j)  (2304 + 64 * (j))
#define XB_TOP      3328
#define XB_TOPGEN   3392
#define XCD_BAR_WORDS 3456
#define XB_SPIN_CAP (1u << 18)

__device__ __forceinline__ unsigned xb_ld(unsigned* p)              { return __hip_atomic_load(p, __ATOMIC_RELAXED, __HIP_MEMORY_SCOPE_AGENT); }
__device__ __forceinline__ unsigned xb_add(unsigned* p, unsigned v) { return __hip_atomic_fetch_add(p, v, __ATOMIC_RELAXED, __HIP_MEMORY_SCOPE_AGENT); }
__device__ __forceinline__ unsigned xb_xcc_id() { return (unsigned)__builtin_amdgcn_s_getreg((3 << 11) | 20) & 0xFu; }
#define XB_SPIN(cond, bar) do { unsigned _sp = 0; while (cond) { __builtin_amdgcn_s_sleep(1); \
    if ((++_sp & 255u) == 0u) { if (xb_ld(&(bar)[XB_TMO])) break; if (_sp > XB_SPIN_CAP) { atomicAdd(&(bar)[XB_TMO], 1u); break; } } } } while (0)

struct XcdBarrier {
    unsigned* bar; unsigned x;
    volatile LAS unsigned* st;
};

__device__ __forceinline__ XcdBarrier xcd_barrier_post(unsigned* bar, volatile LAS unsigned* st) {
    XcdBarrier b; b.bar = bar; b.x = xb_xcc_id(); b.st = st;
    if (threadIdx.x == 0) (void)xb_add(&bar[XB_XCNT(b.x)], 1u);
    return b;
}
__device__ __forceinline__ void xcd_barrier_complete(unsigned* bar, unsigned x, unsigned& nloc, unsigned& nx) {
    const unsigned G = gridDim.x * gridDim.y * gridDim.z;
    unsigned sum, cnt, mine, sp = 0u;
    for (;;) {
        sum = 0u; cnt = 0u; mine = 0u;
#pragma unroll
        for (unsigned j = 0; j < 16; ++j) { const unsigned c = xb_ld(&bar[XB_XCNT(j)]); sum += c; cnt += (c > 0u) ? 1u : 0u; mine = (j == x) ? c : mine; }
        if (sum == G) break;
        __builtin_amdgcn_s_sleep(1);
        if ((++sp & 255u) == 0u) { if (xb_ld(&bar[XB_TMO])) break; if (sp > XB_SPIN_CAP) { atomicAdd(&bar[XB_TMO], 1u); break; } }
    }
    nloc = mine > 0u ? mine : 1u; nx = cnt > 0u ? cnt : 1u;
}

__device__ __forceinline__ void xcd_barrier(const XcdBarrier& b) {
    asm volatile("s_waitcnt vmcnt(0)" ::: "memory");
    __syncthreads();
    if (threadIdx.x == 0) {
        unsigned* bar = b.bar;
        __builtin_amdgcn_s_waitcnt(0);
        unsigned nloc = b.st[0], nx = b.st[1];
        if (nloc == 0u) { xcd_barrier_complete(bar, b.x, nloc, nx); b.st[0] = nloc; b.st[1] = nx; }
        const unsigned old = xb_add(&bar[XB_XSUB(b.x)], 1u);
        const unsigned gen = old / nloc;
        if (old + 1u == (gen + 1u) * nloc) {
            __builtin_amdgcn_fence(__ATOMIC_RELEASE, "agent");
            asm volatile("s_waitcnt vmcnt(0)" ::: "memory");
            const unsigned og = xb_add(&bar[XB_TOP], 1u);
            const unsigned tg = og / nx;
            if (og + 1u == (tg + 1u) * nx) xb_add(&bar[XB_TOPGEN], 1u);
            else XB_SPIN(xb_ld(&bar[XB_TOPGEN]) == tg, bar);
            __builtin_amdgcn_fence(__ATOMIC_ACQUIRE, "agent");
            xb_add(&bar[XB_XGEN(b.x)], 1u);
            asm volatile("s_waitcnt vmcnt(0)" ::: "memory");
        } else {
            XB_SPIN(xb_ld(&bar[XB_XGEN(b.x)]) == gen, bar);
            __builtin_amdgcn_fence(__ATOMIC_ACQUIRE, "agent");
            asm volatile("s_waitcnt vmcnt(0)" ::: "memory");
        }
    }
    __syncthreads();
}

struct Args {
    const float* x; const float* mem; const int* pos; const float* norm_mix_g; const float* w_in; const float* conv_w; const float* conv_b;
    const float* lru_w_a; const float* lru_b_a; const float* lru_w_i; const float* lru_b_i; const float* lru_lambda;
    const float* w_rnn_proj; const float* w_attn_proj; const float* w_mix_out; const float* norm_xq_g; const float* norm_mem_g;
    const float* w_xq; const float* w_xkv; const float* w_xo; const float* norm_ffn_g; const float* w_ffn_gate; const float* w_ffn_up; const float* w_ffn_down; const float* norm_final_g;
    float* out; unsigned char* ws; int ph_lo, ph_hi;
};
constexpr int NPHASE = 13;
#ifndef WGM_WIDE
#define WGM_WIDE 4
#endif
#ifndef WGM_NARROW
#define WGM_NARROW 2
#endif
#ifndef WGM_VT
#define WGM_VT 4
#endif
#ifndef MK_PER_PHASE
#define MK_PER_PHASE 0
#endif

__device__ __forceinline__ unsigned long long ldarg(unsigned off) {
    unsigned long long kp = (unsigned long long)__builtin_amdgcn_kernarg_segment_ptr(), v;
    asm volatile("s_load_dwordx2 %0, %1, %2\n\ts_waitcnt lgkmcnt(0)" : "=s"(v) : "s"(kp), "i"(off) : "memory");
    return v;
}
#define ARGF(field) ((const float*)ldarg((unsigned)__builtin_offsetof(Args, field)))
#define ARGI(field) ((const int*)ldarg((unsigned)__builtin_offsetof(Args, field)))


__global__ void __launch_bounds__(512, 2) fwd(Args a) {
    extern __shared__ __attribute__((aligned(16))) unsigned char lds_raw[];
    LAS unsigned char* lds = (LAS unsigned char*)lds_raw;
    __builtin_assume(__builtin_amdgcn_workitem_id_y() == 0); __builtin_assume(__builtin_amdgcn_workitem_id_z() == 0);
    cg::grid_group grid = cg::this_grid();
    const int tid = threadIdx.x, lane = tid & 63, wave = __builtin_amdgcn_readfirstlane(tid >> 6);
    const int G = gridDim.x, bx = blockIdx.x;
    const int vcu = (G % 8 == 0) ? (bx % 8) * (G / 8) + bx / 8 : bx;
    const int gw = vcu * 8 + wave, NGW = G * 8;
    unsigned char* ws = a.ws;
    bf16_t* Win_t = (bf16_t*)(ws + WS_WIN); bf16_t* Wgu_t = (bf16_t*)(ws + WS_WGU);
    bf16_t* Wa_t = (bf16_t*)(ws + WS_WGATE); bf16_t* Wi_t = (bf16_t*)(ws + WS_WGATE + 512 * 1024);
    bf16_t* Wrnn_t = (bf16_t*)(ws + WS_WRNN); bf16_t* Wattn_t = (bf16_t*)(ws + WS_WATTN); bf16_t* Wmix_t = (bf16_t*)(ws + WS_WMIX);
    bf16_t* Wxq_t = (bf16_t*)(ws + WS_WXQ); bf16_t* Wxkv_t = (bf16_t*)(ws + WS_WXKV); bf16_t* Wxo_t = (bf16_t*)(ws + WS_WXO); bf16_t* Wdown_t = (bf16_t*)(ws + WS_WDOWN);
    bf16_t* K2 = (bf16_t*)(ws + WS_K2); bf16_t* V2T = (bf16_t*)(ws + WS_V2T);
    float* KMEAN = (float*)(ws + WS_KMEAN); float2* CS = (float2*)(ws + WS_CS);
    bf16_t* MEMN = (bf16_t*)(ws + WS_MEMN); bf16_t* H = (bf16_t*)(ws + WS_H);
    bf16_t* XR = (bf16_t*)(ws + WS_XR); bf16_t* GY = (bf16_t*)(ws + WS_GY); bf16_t* Qb = (bf16_t*)(ws + WS_Q); bf16_t* Kb = (bf16_t*)(ws + WS_K); bf16_t* VT = (bf16_t*)(ws + WS_VT);
    bf16_t* ACT = (bf16_t*)(ws + WS_ACT); bf16_t* Q2 = (bf16_t*)(ws + WS_Q2); bf16_t* O2 = (bf16_t*)(ws + WS_O2); bf16_t* T1 = (bf16_t*)(ws + WS_T1);
    bf16_t* SGR = (bf16_t*)a.out; bf16_t* SGA = SGR + SEG_ELEMS;
    float* SSQ1 = (float*)ws; float* SSQ2 = SSQ1 + T;
    const int lo = a.ph_lo, hi = a.ph_hi;
#ifndef PHMASK
#define PHMASK 0xffff
#endif
#define IN(k) (((PHMASK >> (k)) & 1) && lo <= (k) && (k) < hi)
#define LANE_NOW() ({ int t_ = threadIdx.x; asm volatile("" : "+v"(t_)); t_ & 63; })
#define XBAR() do { XcdBarrier xb_; xb_.bar = (unsigned*)(ws + WS_XBAR); xb_.x = xb_xcc_id(); xb_.st = (volatile LAS unsigned*)(lds + LDS_XB_ST); xcd_barrier(xb_); } while (0)
#if MK_PER_PHASE
#define SEAM(k) do { } while (0)
#else
#define SEAM(k) do { if (IN(k) && IN((k) + 1)) { if ((k) == 0) { grid.sync(); (void)xcd_barrier_post((unsigned*)(ws + WS_XBAR), (volatile LAS unsigned*)(lds + LDS_XB_ST)); } else XBAR(); } } while (0)
#endif
#ifndef DUP_PHASE
#define DUP_PHASE -1
#endif
#ifndef DUP_PART
#define DUP_PART 7
#endif
#define REPS(k) ((DUP_PHASE == (k)) ? 2 : 1)
#define REPLOOP(k) for (int rep = 0; rep < REPS(k); ++rep)
#define REPSYNC() do { if (rep) XBAR(); } while (0)
    LAS float* scr = (LAS float*)(lds + wave * 16384);
    if (tid < 2) ((LAS unsigned*)(lds + LDS_XB_ST))[tid] = 0u;
    __syncthreads();

    if (IN(0)) REPLOOP(0) { REPSYNC();
        int it = 0;
        it = tr_matrix(ARGF(w_in), D, 14336, Win_t, RmWin{}, scr, lane, gw, NGW, it);
        it = tr_matrix(ARGF(w_rnn_proj), D, D, Wrnn_t, RmId{}, scr, lane, gw, NGW, it);
        it = tr_matrix(ARGF(w_attn_proj), D, D, Wattn_t, RmId{}, scr, lane, gw, NGW, it);
        it = tr_matrix(ARGF(w_mix_out), D, D, Wmix_t, RmId{}, scr, lane, gw, NGW, it);
        it = tr_matrix(ARGF(w_xq), D, DMEM, Wxq_t, RmId{}, scr, lane, gw, NGW, it);
        it = tr_matrix(ARGF(w_xkv), D, 2 * DMEM, Wxkv_t, RmId{}, scr, lane, gw, NGW, it);
        it = tr_matrix(ARGF(w_xo), DMEM, D, Wxo_t, RmId{}, scr, lane, gw, NGW, it);
        for (int blk = 0; blk < 16; ++blk) {
            it = tr_matrix(ARGF(lru_w_a) + blk * 16384, 128, 128, Wa_t + blk * 16384, RmId{}, scr, lane, gw, NGW, it);
            it = tr_matrix(ARGF(lru_w_i) + blk * 16384, 128, 128, Wi_t + blk * 16384, RmId{}, scr, lane, gw, NGW, it);
        }
        const int gt = vcu * 512 + tid, GT = G * 512;
        const int* posp = ARGI(pos);
        for (int i = gt; i < T * 16; i += GT) {
            const int t = i >> 4, f = i & 15;
            const float invf = powf(500000.0f, -(float)f * (1.0f / 16.0f));
            const float ang = (float)posp[t] * invf;
            double rev = (double)ang * 0.15915494309189535; rev -= rint(rev);
            float2 v; v.x = __builtin_amdgcn_cosf((float)rev); v.y = __builtin_amdgcn_sinf((float)rev);
            CS[i] = v;
        }
        for (int i = gt; i < 64 * D; i += GT) KMEAN[i] = 0.f;
        for (int i = gt; i < 2 * T; i += GT) SSQ1[i] = 0.f;
        if (bx == 0) for (int i = tid; i < XCD_BAR_WORDS; i += 512) ((unsigned*)(ws + WS_XBAR))[i] = 0u;
        norm_rows<false>(ARGF(x), ARGF(norm_mix_g), H, T, gw, NGW, lane);
        norm_rows<false>(ARGF(mem), ARGF(norm_mem_g), MEMN, NB * MEML, gw, NGW, lane);
    }
    SEAM(0);
    if (IN(1)) REPLOOP(1) { REPSYNC();
        if (rep == REPS(1) - 1 || (DUP_PART & 1)) { Gemm g{H, Win_t, T, NIN1, D}; StaticOrder S; S.init(T, NIN1, G, bx, WGM_WIDE); EpiInProj E{XR, SGR, CS, KMEAN};
          gemm_phase<EpiInProj, StaticOrder, true, true>(lds, g, S, E); }
        if (rep == REPS(1) - 1 || (DUP_PART & 2)) { Gemm g{Win_t + (size_t)NIN1 * D, H, D, T, D}; StaticOrder S; S.init(D, T, G, bx, WGM_VT); EpiStore E{VT, T, 1.f};
          gemm_phase<EpiStore, StaticOrder, true, true>(lds, g, S, E); }
    }
    SEAM(1);
#define P2_BODY(OOUT, PARTS, NOST) do { \
        if ((PARTS) & 1) conv_prepass(XR, H, ARGF(conv_w), ARGF(conv_b), vcu * 512 + tid, G * 512); \
        if (vcu < 256 && ((PARTS) & 2)) { const int bh = vcu >> 2, sub = vcu & 3, b = bh >> 4, h = bh & 15; \
            _Pragma("unroll 1") for (int ui = 0; ui < 4; ++ui) { \
                const int j = (ui == 0) ? sub : (ui == 1) ? 7 - sub : (ui == 2) ? 8 + sub : 15 - sub; \
                const size_t qoff = ((size_t)b * SEQ + 256 * j) * D + h * HD; \
                attn_unit<true>(lds, Qb + qoff, D, Kb + (size_t)b * SEQ * D + h * HD, D, VT + (size_t)(h * HD) * T + (size_t)b * SEQ, T, (OOUT) + qoff, D, 4 * (j + 1), j, KMEAN + (size_t)(b * 16) * D + h * HD, (NOST)); } } \
        if ((PARTS) & 4) { int it = 0; \
          it = tr_matrix(ARGF(w_ffn_gate), D, DFF, Wgu_t, RmGu{0}, scr, LANE_NOW(), gw, NGW, it); \
          it = tr_matrix(ARGF(w_ffn_up), D, DFF, Wgu_t, RmGu{1}, scr, LANE_NOW(), gw, NGW, it); \
          (void)it; } } while (0)
    if (IN(2)) {
#if DUP_PHASE == 2
        P2_BODY(Qb, DUP_PART, 1); XBAR();
#endif
        P2_BODY(Qb, 2, 0);
        P2_BODY(Qb, 5, 0);
    }
    if (IN(2)) XBAR();
    if (IN(2)) {
#if DUP_PHASE == 13
        if (vcu < 256) { RnnP P{H, GY, T1, Wa_t, Wi_t, ARGF(lru_b_a), ARGF(lru_b_i), ARGF(lru_lambda)}; rnn_unit(lds, P, vcu >> 6, (vcu >> 2) & 15, vcu & 3); }
        grid.sync();
#endif
        if (vcu < 256) { RnnP P{H, GY, GY, Wa_t, Wi_t, ARGF(lru_b_a), ARGF(lru_b_i), ARGF(lru_lambda)}; rnn_unit(lds, P, vcu >> 6, (vcu >> 2) & 15, vcu & 3); }
    }
    SEAM(2);
    if (IN(3)) REPLOOP(3) { REPSYNC();
        { Gemm g{GY, Wrnn_t, T, D, D, Qb, Wattn_t, D / 64}; StaticOrder S; S.init(T, D, G, bx, WGM_NARROW); EpiGate2 E{SGR, SGA, H};
          gemm_phase<EpiGate2, StaticOrder, true, true>(lds, g, S, E); }
    }
    SEAM(3);
    if (IN(4)) REPLOOP(4) { REPSYNC(); Gemm g{H, Wmix_t, T, D, D}; StaticOrder S; S.init(T, D, G, bx, WGM_NARROW); EpiResidNorm E{ARGF(x), a.out, GY, ARGF(norm_xq_g), SSQ1};
        gemm_phase<EpiResidNorm, StaticOrder, true, true>(lds, g, S, E); }
    SEAM(4);
#ifdef EXTRA_SYNCS
    for (int es = 0; es < EXTRA_SYNCS; ++es) grid.sync();
#endif
    if (IN(6)) REPLOOP(6) { REPSYNC();
        { Gemm g{GY, Wxq_t, T, DMEM, D}; StaticOrder S; S.init(T, DMEM, G, bx); EpiStoreRS E{Q2, DMEM, QSCALE, SSQ1};
          gemm_phase<EpiStoreRS, StaticOrder, true, true>(lds, g, S, E); }
        { Gemm g{MEMN, Wxkv_t, NB * MEML, DMEM, D}; StaticOrder S; S.init(NB * MEML, DMEM, G, (bx + G - 128 % G) % G); EpiStore E{K2, DMEM, 1.f};
          gemm_phase<EpiStore, StaticOrder, true, true>(lds, g, S, E); }
        { Gemm g{Wxkv_t + (size_t)DMEM * D, MEMN, DMEM, NB * MEML, D}; StaticOrder S; S.init(DMEM, NB * MEML, G, (bx + G - 136 % G) % G); EpiStore E{V2T, NB * MEML, 1.f};
          gemm_phase<EpiStore, StaticOrder, true, true>(lds, g, S, E); }
        if (bx >= 144) (void)tr_matrix(ARGF(w_ffn_down), DFF, D, Wdown_t, RmId{}, scr, LANE_NOW(), (bx - 144) * 8 + wave, (G - 144) * 8, 0);
    }
    SEAM(6);
    if (IN(7)) REPLOOP(7) { REPSYNC();
#ifndef P7_REPS
#define P7_REPS 1
#endif
        for (int r7 = 0; r7 < P7_REPS; ++r7)
        for (int u0 = vcu; u0 < 256; u0 += G) { const int u = (u0 + 64 * r7 + 16 * r7 + r7) & 255; const int b = u >> 6, mh = (u >> 4) & 3, qb = u & 15;
            const size_t qoff = ((size_t)b * SEQ + 256 * qb) * DMEM + mh * HD;
            attn_unit<true>(lds, Q2 + qoff, DMEM, K2 + (size_t)(b * MEML) * DMEM + mh * HD, DMEM, V2T + (size_t)(mh * HD) * (NB * MEML) + b * MEML, NB * MEML, O2 + qoff, DMEM, 4, 1, nullptr); }
    }
    SEAM(7);
    if (IN(8)) { Gemm g{O2, Wxo_t, T, D, DMEM}; StaticOrder S; S.init(T, D, G, bx, WGM_NARROW); EpiResidNorm E{a.out, a.out, H, ARGF(norm_ffn_g), SSQ2};
        gemm_phase<EpiResidNorm, StaticOrder, true, true>(lds, g, S, E); }
    SEAM(8);
    if (IN(10)) REPLOOP(10) { REPSYNC(); Gemm g{H, Wgu_t, T, 2 * DFF, D}; StaticOrder S; S.init(T, 2 * DFF, G, bx, WGM_WIDE); EpiSwigluRS E{ACT, SSQ2};
        gemm_phase<EpiSwigluRS, StaticOrder, true, true>(lds, g, S, E); }
    SEAM(10);
    if (IN(11)) { Gemm g{ACT, Wdown_t, T, D, DFF}; StaticOrder S; S.init(T, D, G, bx, WGM_NARROW); EpiResid E{a.out, a.out};
        gemm_phase<EpiResid, StaticOrder, true, true>(lds, g, S, E); }
    SEAM(11);
    if (IN(12)) norm_rows<true>(a.out, ARGF(norm_final_g), a.out, T, gw, NGW, LANE_NOW());
#undef IN
#undef SEAM
}

extern "C" void kernel_launch(void* const* d_in, const int* in_sizes, int n_in, void* d_out, int out_size, void* d_ws, size_t ws_size, hipStream_t stream) {
    static int grid = 0;
    if (grid == 0) {
        if (n_in != 25 || out_size != T * D || ws_size < WS_END) { fprintf(stderr, "kernel_launch: unexpected problem (n_in %d out %d ws %zu)\n", n_in, out_size, ws_size); grid = -1; return; }
        int dev = 0, cus = 0, per_cu = 0;
        (void)hipGetDevice(&dev);
        (void)hipDeviceGetAttribute(&cus, hipDeviceAttributeMultiprocessorCount, dev);
        (void)hipFuncSetAttribute((const void*)fwd, hipFuncAttributeMaxDynamicSharedMemorySize, LDS_BYTES);
        (void)hipOccupancyMaxActiveBlocksPerMultiprocessor(&per_cu, (const void*)fwd, 512, LDS_BYTES);
        fprintf(stderr, "kernel_launch: cus %d per_cu %d ws %zu\n", cus, per_cu, ws_size);
        grid = cus > 256 ? 256 : cus;
        if (grid != 256) fprintf(stderr, "kernel_launch: expected 256 CUs, got %d\n", cus);
    }
    if (grid < 0) return;
    Args a{};
    a.x = (const float*)d_in[0]; a.mem = (const float*)d_in[1]; a.pos = (const int*)d_in[2]; a.norm_mix_g = (const float*)d_in[3]; a.w_in = (const float*)d_in[4];
    a.conv_w = (const float*)d_in[5]; a.conv_b = (const float*)d_in[6]; a.lru_w_a = (const float*)d_in[7]; a.lru_b_a = (const float*)d_in[8]; a.lru_w_i = (const float*)d_in[9];
    a.lru_b_i = (const float*)d_in[10]; a.lru_lambda = (const float*)d_in[11]; a.w_rnn_proj = (const float*)d_in[12]; a.w_attn_proj = (const float*)d_in[13]; a.w_mix_out = (const float*)d_in[14];
    a.norm_xq_g = (const float*)d_in[15]; a.norm_mem_g = (const float*)d_in[16]; a.w_xq = (const float*)d_in[17]; a.w_xkv = (const float*)d_in[18]; a.w_xo = (const float*)d_in[19];
    a.norm_ffn_g = (const float*)d_in[20]; a.w_ffn_gate = (const float*)d_in[21]; a.w_ffn_up = (const float*)d_in[22]; a.w_ffn_down = (const float*)d_in[23]; a.norm_final_g = (const float*)d_in[24];
    a.out = (float*)d_out; a.ws = (unsigned char*)d_ws;
#if MK_PER_PHASE
    for (int ph = 0; ph < NPHASE; ++ph) {
        a.ph_lo = ph; a.ph_hi = ph + 1; void* args[] = {&a};
        hipError_t e = hipLaunchCooperativeKernel((const void*)fwd, dim3(grid), dim3(512), args, LDS_BYTES, stream);
        if (e != hipSuccess) { fprintf(stderr, "launch %d failed: %s\n", ph, hipGetErrorString(e)); break; }
    }
#else
    a.ph_lo = 0; a.ph_hi = NPHASE; void* args[] = {&a};
    hipError_t e = hipLaunchCooperativeKernel((const void*)fwd, dim3(grid), dim3(512), args, LDS_BYTES, stream);
    if (e != hipSuccess) fprintf(stderr, "cooperative launch failed: %s (grid %d)\n", hipGetErrorString(e), grid);
#endif
}
```
